# Optimizing an MI355X kernel written in HIP

```python
import jax, jax.numpy as jnp
from jax import lax
import numpy as np

D_MODEL = 1024
BATCH = 8
SEQ = 8192
DEPTH = 2

CONV_WIDTH = D_MODEL // 2
POOL_WIDTH = D_MODEL - CONV_WIDTH
MIX_WIDTH = CONV_WIDTH + POOL_WIDTH
IN_WIDTH = 2 * CONV_WIDTH + POOL_WIDTH
CONV_KERNEL = 31
POOL_WINDOWS = (2, 4, 8, 16)
N_POOL_GROUPS = len(POOL_WINDOWS)
POOL_GROUP_DIM = POOL_WIDTH // N_POOL_GROUPS
N_EXPERTS = 32
N_EXPERT_GROUPS = 4
EXPERTS_PER_GROUP = N_EXPERTS // N_EXPERT_GROUPS
TOP_K = 2
D_EXPERT = D_MODEL // 2
EXPERT_BLOCK = 128
LN_EPS = 1e-5
DEEPNORM_ALPHA = (2 * DEPTH) ** 0.25
DEEPNORM_BETA = (8 * DEPTH) ** -0.25

kernel_name = 'hybrid_conv_pool_moe_deepnorm'


def _layer_norm(x, g, b):
    xf = x.astype(jnp.float32)
    mu = xf.mean(-1, keepdims=True)
    var = jnp.square(xf - mu).mean(-1, keepdims=True)
    y = (xf - mu) * lax.rsqrt(var + LN_EPS) * g.astype(jnp.float32) + b.astype(jnp.float32)
    return y.astype(x.dtype)


def _conformer_conv_group(a, gate, conv_w, conv_b, ln_g, ln_b):
    v = a * jax.nn.sigmoid(gate)
    y = lax.conv_general_dilated(
        v, conv_w[:, None, :].astype(v.dtype), window_strides=(1,),
        padding=[(CONV_KERNEL - 1, 0)], dimension_numbers=('NWC', 'WIO', 'NWC'),
        feature_group_count=CONV_WIDTH) + conv_b.astype(v.dtype)
    y = _layer_norm(y, ln_g, ln_b)
    return jax.nn.silu(y)


def _multiscale_pool_group(p, pool_w, pool_scale):
    B, S, _ = p.shape
    pf = p.astype(jnp.float32).reshape(B, S, N_POOL_GROUPS, POOL_GROUP_DIM)
    csum = jnp.cumsum(pf, axis=1)
    csum = jnp.concatenate([jnp.zeros_like(csum[:, :1]), csum], axis=1)
    pos = jnp.arange(S) + 1
    outs = []
    for gi, w in enumerate(POOL_WINDOWS):
        cg = csum[:, :, gi]
        upper = cg[:, 1:]
        lower = jnp.concatenate([jnp.zeros_like(cg[:, :w - 1]), cg[:, :S + 1 - w]], axis=1)
        cnt = jnp.minimum(pos, w).astype(jnp.float32)[None, :, None]
        outs.append((upper - lower) / cnt - pf[:, :, gi])
    d = jnp.stack(outs, axis=2)
    y = jnp.einsum('bsgc,gcd->bsgd', d, pool_w.astype(jnp.float32)).reshape(B, S, POOL_WIDTH)
    return (y * pool_scale.astype(jnp.float32)).astype(p.dtype)


def _grouped_moe(u, w_router, router_bias, wg, wu, wd):
    B, S, D = u.shape
    T = B * S
    uf = u.reshape(T, D)
    scores = jax.nn.sigmoid((uf @ w_router.astype(uf.dtype)).astype(jnp.float32))
    sel = scores + router_bias.astype(jnp.float32)
    sel_g = sel.reshape(T, N_EXPERT_GROUPS, EXPERTS_PER_GROUP)
    grp_score = lax.top_k(sel_g, TOP_K)[0].sum(-1)
    g_star = jnp.argmax(grp_score, axis=-1)
    in_grp = jnp.take_along_axis(sel_g, g_star[:, None, None], axis=1)[:, 0]
    _, loc = lax.top_k(in_grp, TOP_K)
    idx = g_star[:, None] * EXPERTS_PER_GROUP + loc
    wts = jnp.take_along_axis(scores, idx, axis=1)
    wts = wts / wts.sum(-1, keepdims=True)

    A = T * TOP_K
    P = A + N_EXPERTS * EXPERT_BLOCK
    NB = P // EXPERT_BLOCK
    flat_e = idx.reshape(A).astype(jnp.int32)
    flat_tok = jnp.repeat(jnp.arange(T, dtype=jnp.int32), TOP_K)
    flat_w = wts.reshape(A)
    order = jnp.argsort(flat_e, stable=True)
    se = flat_e[order]
    counts = jnp.bincount(flat_e, length=N_EXPERTS)
    starts = jnp.cumsum(counts) - counts
    pcounts = (counts + EXPERT_BLOCK - 1) // EXPERT_BLOCK * EXPERT_BLOCK
    pends = jnp.cumsum(pcounts)
    pstarts = pends - pcounts
    dest = pstarts[se] + jnp.arange(A, dtype=jnp.int32) - starts[se]
    buf_tok = jnp.full((P,), T, jnp.int32).at[dest].set(flat_tok[order])
    buf_w = jnp.zeros((P,), jnp.float32).at[dest].set(flat_w[order])
    blk_e = jnp.clip(jnp.searchsorted(pends, jnp.arange(NB) * EXPERT_BLOCK, side='right'), 0, N_EXPERTS - 1)
    x_pad = jnp.concatenate([uf, jnp.zeros((1, D), uf.dtype)], axis=0)

    def expert_block(args):
        tok, e = args
        xb = x_pad[tok]
        h = jax.nn.silu(xb @ wg[e]) * (xb @ wu[e])
        return h @ wd[e]

    out = lax.map(expert_block, (buf_tok.reshape(NB, EXPERT_BLOCK), blk_e))
    out = out.reshape(P, D) * buf_w[:, None].astype(out.dtype)
    y = jnp.zeros((T + 1, D), out.dtype).at[buf_tok].add(out)[:T]
    return y.reshape(B, S, D)


def setup_inputs(seed: int = 0) -> dict:
    key = jax.random.key(seed)
    ks = jax.random.split(key, 23)
    f32 = jnp.float32

    def nrm(k, shape, std):
        return jax.random.normal(k, shape, f32) * std

    D, L = D_MODEL, DEPTH
    return {
        'x': nrm(ks[0], (BATCH, SEQ, D), 1.0),
        'c': nrm(ks[1], (BATCH, D), 1.0),
        'w_ada': nrm(ks[2], (L, D, 6 * D), 0.2 * D ** -0.5),
        'b_ada': nrm(ks[3], (L, 6 * D), 0.02),
        'w_in': nrm(ks[4], (L, D, IN_WIDTH), D ** -0.5),
        'b_in': nrm(ks[5], (L, IN_WIDTH), 0.02),
        'conv_w': nrm(ks[6], (L, CONV_KERNEL, CONV_WIDTH), CONV_KERNEL ** -0.5),
        'conv_b': nrm(ks[7], (L, CONV_WIDTH), 0.02),
        'conv_ln_g': 1.0 + nrm(ks[8], (L, CONV_WIDTH), 0.02),
        'conv_ln_b': nrm(ks[9], (L, CONV_WIDTH), 0.02),
        'pool_w': nrm(ks[10], (L, N_POOL_GROUPS, POOL_GROUP_DIM, POOL_GROUP_DIM), POOL_GROUP_DIM ** -0.5),
        'pool_scale': 1.0 + nrm(ks[11], (L, POOL_WIDTH), 0.02),
        'w_out': nrm(ks[12], (L, MIX_WIDTH, D), MIX_WIDTH ** -0.5 * DEEPNORM_BETA),
        'b_out': nrm(ks[13], (L, D), 0.02),
        'ln1_g': 1.0 + nrm(ks[14], (L, D), 0.02),
        'ln1_b': nrm(ks[15], (L, D), 0.02),
        'w_router': nrm(ks[16], (D, N_EXPERTS), D ** -0.5),
        'router_bias': nrm(ks[17], (N_EXPERTS,), 0.01),
        'w_gate': nrm(ks[18], (L, N_EXPERTS, D, D_EXPERT), D ** -0.5),
        'w_up': nrm(ks[19], (L, N_EXPERTS, D, D_EXPERT), D ** -0.5),
        'w_down': nrm(ks[20], (L, N_EXPERTS, D_EXPERT, D), D_EXPERT ** -0.5 * DEEPNORM_BETA),
        'ln2_g': 1.0 + nrm(ks[21], (L, D), 0.02),
        'ln2_b': nrm(ks[22], (L, D), 0.02),
    }


def reference(x, c, w_ada, b_ada, w_in, b_in, conv_w, conv_b, conv_ln_g, conv_ln_b,
              pool_w, pool_scale, w_out, b_out, ln1_g, ln1_b, w_router, router_bias,
              w_gate, w_up, w_down, ln2_g, ln2_b):
    c_act = jax.nn.silu(c)
    for l in range(DEPTH):
        mod = c_act @ w_ada[l] + b_ada[l]
        sh1, sc1, g1, sh2, sc2, g2 = [m[:, None, :] for m in jnp.split(mod, 6, axis=-1)]

        u = x * (1.0 + sc1) + sh1
        h = u @ w_in[l] + b_in[l]
        a = h[..., :CONV_WIDTH]
        gate = h[..., CONV_WIDTH:2 * CONV_WIDTH]
        p = h[..., 2 * CONV_WIDTH:]
        ya = _conformer_conv_group(a, gate, conv_w[l], conv_b[l], conv_ln_g[l], conv_ln_b[l])
        yb = _multiscale_pool_group(p, pool_w[l], pool_scale[l])
        mix = jnp.concatenate([ya, yb], axis=-1) @ w_out[l] + b_out[l]
        x = _layer_norm(DEEPNORM_ALPHA * x + (1.0 + g1) * mix, ln1_g[l], ln1_b[l])

        u2 = x * (1.0 + sc2) + sh2
        f = _grouped_moe(u2, w_router, router_bias, w_gate[l], w_up[l], w_down[l])
        x = _layer_norm(DEEPNORM_ALPHA * x + (1.0 + g2) * f, ln2_g[l], ln2_b[l])
    return x
```

```cpp
#include <hip/hip_runtime.h>
#include <cstdio>
#include <cstdint>

#define GAS __attribute__((address_space(1)))
#define LAS __attribute__((address_space(3)))
typedef unsigned short bf16;
typedef short bf16x8 __attribute__((ext_vector_type(8)));
typedef float f32x4 __attribute__((ext_vector_type(4)));
typedef float f32x2 __attribute__((ext_vector_type(2)));
typedef unsigned u32x4 __attribute__((ext_vector_type(4)));
typedef unsigned u32x2 __attribute__((ext_vector_type(2)));

constexpr int NB = 8, SEQ = 8192, D = 1024, M = NB * SEQ, L = 2;
constexpr int CW = 512, INW = 1536, CK = 31, NE = 32, FE = 512;
constexpr float LN_EPS = 1e-5f;
constexpr float ALPHA = 1.4142135623730951f;
constexpr int NWAVES = 8, NT = 512;
constexpr int LDS_BYTES = 163840;
constexpr int LISTCAP = 65536;

constexpr size_t MiB = 1u << 20;
constexpr size_t WS_CTL = 0, CTL_ZERO_BYTES = 65536;
constexpr size_t WS_MOD = 1 * MiB;
constexpr size_t WS_MODP = 2 * MiB;
constexpr size_t WS_WR = 9 * MiB;
constexpr size_t WS_STATS = 10 * MiB;
constexpr size_t WS_LISTD = 12 * MiB;
constexpr size_t WS_LISTW = 20 * MiB;
constexpr size_t WS_WIN = 28 * MiB;
constexpr size_t WS_WOUT = 34 * MiB;
constexpr size_t WS_WGU = 38 * MiB;
constexpr size_t WS_WD = 166 * MiB;
constexpr size_t WS_A = 232 * MiB;
constexpr size_t WS_B = 360 * MiB;
constexpr size_t WS_C = 504 * MiB;
constexpr size_t WS_D = 632 * MiB;
constexpr size_t WS_E = 888 * MiB;
constexpr size_t WS_PART = 488 * MiB;
constexpr size_t WS_END = 1016 * MiB;
constexpr int CW_CNT = 64;
constexpr int CW_BAR = 1024;
constexpr int LDS_EPIC = 145 * 1024;
constexpr int LDS_OFFS = 134 * 1024;
constexpr int LDS_MISC = 133 * 1024;

#define LDS_WAIT() asm volatile("s_waitcnt lgkmcnt(0)" ::: "memory")
typedef __bf16 bf16v2 __attribute__((ext_vector_type(2)));
typedef _Float16 h16x2 __attribute__((ext_vector_type(2)));
__device__ __forceinline__ unsigned pk2h(float lo, float hi) { return __builtin_bit_cast(unsigned, __builtin_convertvector((f32x2){lo, hi}, h16x2)); }
__device__ __forceinline__ unsigned pk2(float lo, float hi) { return __builtin_bit_cast(unsigned, __builtin_convertvector((f32x2){lo, hi}, bf16v2)); }
__device__ __forceinline__ unsigned f2bf(float f) { return pk2(f, 0.f) & 0xffffu; }
__device__ __forceinline__ float bflo(unsigned u) { return __builtin_bit_cast(float, u << 16); }
__device__ __forceinline__ float bfhi(unsigned u) { return __builtin_bit_cast(float, u & 0xffff0000u); }
__device__ __forceinline__ float bf2f(bf16 b) { return __builtin_bit_cast(float, ((unsigned)b) << 16); }
__device__ __forceinline__ unsigned pk4_fp8(float a, float b, float c, float d) { unsigned r = __builtin_amdgcn_cvt_pk_fp8_f32(a, b, 0u, false); return __builtin_amdgcn_cvt_pk_fp8_f32(c, d, r, true); }
__device__ __forceinline__ float clamp_fp8(float x) { return __builtin_fminf(__builtin_fmaxf(x, -448.0f), 448.0f); }
__device__ __forceinline__ float fmac1(float acc, float a, float b) {
#if defined(__HIP_DEVICE_COMPILE__)
    asm("v_fmac_f32 %0, %1, %2" : "+v"(acc) : "v"(a), "v"(b));
#endif
    return acc;
}
__device__ __forceinline__ float sigmoidf_(float x) { return __builtin_amdgcn_rcpf(1.0f + __builtin_amdgcn_exp2f(x * -1.44269504089f)); }
__device__ __forceinline__ float wave_sum(float v) {
    v += __builtin_bit_cast(float, __builtin_amdgcn_update_dpp(0, __builtin_bit_cast(int, v), 0xB1, 0xf, 0xf, true));
    v += __builtin_bit_cast(float, __builtin_amdgcn_update_dpp(0, __builtin_bit_cast(int, v), 0x4E, 0xf, 0xf, true));
    v += __builtin_bit_cast(float, __builtin_amdgcn_update_dpp(0, __builtin_bit_cast(int, v), 0x141, 0xf, 0xf, true));
    v += __builtin_bit_cast(float, __builtin_amdgcn_update_dpp(0, __builtin_bit_cast(int, v), 0x140, 0xf, 0xf, true));
    const float a = __builtin_bit_cast(float, __builtin_amdgcn_readlane(__builtin_bit_cast(int, v), 0)), b = __builtin_bit_cast(float, __builtin_amdgcn_readlane(__builtin_bit_cast(int, v), 16));
    const float c = __builtin_bit_cast(float, __builtin_amdgcn_readlane(__builtin_bit_cast(int, v), 32)), d = __builtin_bit_cast(float, __builtin_amdgcn_readlane(__builtin_bit_cast(int, v), 48));
    return (a + b) + (c + d);
}

struct Args { const float* in[23]; float* out; unsigned char* ws; int ph_lo, ph_hi; };
enum { I_X = 0, I_C, I_WADA, I_BADA, I_WIN, I_BIN, I_CONVW, I_CONVB, I_CLNG, I_CLNB, I_POOLW, I_POOLS, I_WOUT, I_BOUT, I_LN1G, I_LN1B, I_WR, I_RB, I_WG, I_WU, I_WDN, I_LN2G, I_LN2B };

struct Unit { int pm, pn; };
struct StaticOrder {
    int nM, nN, nwg, G, c;
    __device__ void init(int nM_, int nN_, int G_, int c_) { nM = nM_; nN = nN_; nwg = nM * nN; G = G_; c = c_; }
    __device__ bool next(int i, Unit& u) const {
        const long Lq = (long)i * G + c; if (Lq >= nwg) return false;
        int wgid = (int)Lq; { const int q = nwg / 8, r = nwg % 8, xcd = wgid % 8, off = wgid / 8; wgid = (xcd < r ? xcd * (q + 1) : r * (q + 1) + (xcd - r) * q) + off; }
        const int nig = 8 * nN, gid = wgid / nig, fm = gid * 8, gsz = (nM - fm) < 8 ? (nM - fm) : 8;
        u.pm = fm + ((wgid % nig) % gsz); u.pn = (wgid % nig) / gsz; return true;
    }
};

template <int NM, int NN> struct StaticOrderC {
    int G, c;
    __device__ void init(int, int, int G_, int c_) { G = G_; c = c_; }
    __device__ __forceinline__ bool next(int i, Unit& u) const {
        if (G == NM) { u.pm = c; u.pn = i; return i < NN; }
        constexpr int nwg = NM * NN, q = nwg / 8, r = nwg % 8, nig = 8 * NN;
        const int Lq = i * G + c; if (Lq >= nwg) return false;
        const unsigned w0 = (unsigned)Lq, xcd = w0 % 8u, off = w0 / 8u; const unsigned wgid = (xcd < (unsigned)r ? xcd * (q + 1) : r * (q + 1) + (xcd - r) * q) + off;
        static_assert(NM % 8 == 0, "row-tile groups of 8");
        const unsigned gid = wgid / (unsigned)nig, fm = gid * 8u, rem = wgid % (unsigned)nig;
        u.pm = (int)(fm + rem % 8u); u.pn = (int)(rem / 8u); return true;
    }
};

__device__ __forceinline__ void unpack8(const u32x4 v, float (&e)[8]) { e[0] = bflo(v.x); e[1] = bfhi(v.x); e[2] = bflo(v.y); e[3] = bfhi(v.y); e[4] = bflo(v.z); e[5] = bfhi(v.z); e[6] = bflo(v.w); e[7] = bfhi(v.w); }
__device__ __forceinline__ u32x4 pack8(const float (&o)[8]) { return (u32x4){pk2(o[0], o[1]), pk2(o[2], o[3]), pk2(o[4], o[5]), pk2(o[6], o[7])}; }
#define EPI_ROW(ai, m) ((ai) * 128 + wr * 64 + (m) * 16 + fr)
struct Epi1 {
    bf16* __restrict__ vp; const LAS float* b_in; int row0, pn;
    __device__ __forceinline__ void run(const f32x4 (&acc)[2][2][4][2], int wr, int wc, int fr, int fq) const {
        const int c8 = wc * 32 + 8 * fq;
        if (pn < 4) {
            const int c = pn * 128 + c8; const f32x4 bal = *(const LAS f32x4*)(b_in + c), bah = *(const LAS f32x4*)(b_in + c + 4), bgl = *(const LAS f32x4*)(b_in + 512 + c), bgh = *(const LAS f32x4*)(b_in + 512 + c + 4);
#pragma unroll
            for (int ai = 0; ai < 2; ++ai)
#pragma unroll
                for (int m = 0; m < 4; ++m) { float o[8];
#pragma unroll
                    for (int j = 0; j < 4; ++j) { o[j] = (acc[ai][0][m][0][j] * 0.03125f + bal[j]) * sigmoidf_(acc[ai][1][m][0][j] * 0.03125f + bgl[j]); o[4 + j] = (acc[ai][0][m][1][j] * 0.03125f + bah[j]) * sigmoidf_(acc[ai][1][m][1][j] * 0.03125f + bgh[j]); }
                    *(u32x4*)(vp + (size_t)(row0 + EPI_ROW(ai, m)) * D + c) = (u32x4){pk2h(o[0], o[1]), pk2h(o[2], o[3]), pk2h(o[4], o[5]), pk2h(o[6], o[7])}; }
        } else {
            const int c = (pn - 4) * 256 + c8; const f32x4 b0l = *(const LAS f32x4*)(b_in + 1024 + c), b0h = *(const LAS f32x4*)(b_in + 1024 + c + 4), b1l = *(const LAS f32x4*)(b_in + 1152 + c), b1h = *(const LAS f32x4*)(b_in + 1152 + c + 4);
#pragma unroll
            for (int ai = 0; ai < 2; ++ai)
#pragma unroll
                for (int m = 0; m < 4; ++m) { float o0[8], o1[8];
#pragma unroll
                    for (int j = 0; j < 4; ++j) { o0[j] = acc[ai][0][m][0][j] * 0.03125f + b0l[j]; o0[4 + j] = acc[ai][0][m][1][j] * 0.03125f + b0h[j]; o1[j] = acc[ai][1][m][0][j] * 0.03125f + b1l[j]; o1[4 + j] = acc[ai][1][m][1][j] * 0.03125f + b1h[j]; }
                    bf16* rowp = vp + (size_t)(row0 + EPI_ROW(ai, m)) * D + 512 + c;
                    *(u32x4*)(rowp) = pack8(o0); *(u32x4*)(rowp + 128) = pack8(o1); }
        }
    }
};
struct Epi2 {
    bf16* __restrict__ y; const bf16* __restrict__ xb; const LAS float* bo; const LAS float* gg; float* __restrict__ part; int row0, pn;
    __device__ __forceinline__ void rows(const f32x4 (&acc)[2][2][4][2], const int ai, const u32x4 (&xr)[4][2], const int c8, u32x4 (&out)[4][2], f32x2 (&st)[4]) const {
#pragma unroll
        for (int m = 0; m < 4; ++m) { float s = 0.f, q = 0.f;
#pragma unroll
            for (int h = 0; h < 2; ++h) { const int c = pn * 256 + h * 128 + c8;
                const f32x4 b0 = *(const LAS f32x4*)(bo + c), b1 = *(const LAS f32x4*)(bo + c + 4), g0 = *(const LAS f32x4*)(gg + c), g1v = *(const LAS f32x4*)(gg + c + 4);
                float x8[8]; unpack8(xr[m][h], x8); float o[8];
#pragma unroll
                for (int j = 0; j < 4; ++j) { o[j] = ALPHA * x8[j] + g0[j] * (acc[ai][h][m][0][j] * 0.015625f + b0[j]); o[4 + j] = ALPHA * x8[4 + j] + g1v[j] * (acc[ai][h][m][1][j] * 0.015625f + b1[j]); }
                out[m][h] = pack8(o); float e[8]; unpack8(out[m][h], e);
#pragma unroll
                for (int j = 0; j < 8; ++j) { s += e[j]; q += e[j] * e[j]; } }
            st[m] = (f32x2){s, q}; }
#pragma unroll
        for (int m = 0; m < 4; ++m) { st[m].x += __shfl_xor(st[m].x, 16); st[m].y += __shfl_xor(st[m].y, 16); }
#pragma unroll
        for (int m = 0; m < 4; ++m) { st[m].x += __shfl_xor(st[m].x, 32); st[m].y += __shfl_xor(st[m].y, 32); }
    }
    __device__ __forceinline__ void run(const f32x4 (&acc)[2][2][4][2], int wr, int wc, int fr, int fq) const {
        const int c8 = wc * 32 + 8 * fq;
        u32x4 xr[4][2], out0[4][2], out1[4][2]; f32x2 st0[4], st1[4];
#pragma unroll
        for (int m = 0; m < 4; ++m)
#pragma unroll
            for (int h = 0; h < 2; ++h) xr[m][h] = __builtin_nontemporal_load((const u32x4*)(xb + (size_t)(row0 + EPI_ROW(0, m)) * D + pn * 256 + h * 128 + c8));
        rows(acc, 0, xr, c8, out0, st0);
#pragma unroll
        for (int m = 0; m < 4; ++m)
#pragma unroll
            for (int h = 0; h < 2; ++h) xr[m][h] = __builtin_nontemporal_load((const u32x4*)(xb + (size_t)(row0 + EPI_ROW(1, m)) * D + pn * 256 + h * 128 + c8));
        rows(acc, 1, xr, c8, out1, st1);
#pragma unroll
        for (int m = 0; m < 4; ++m) { const size_t ro = (size_t)(row0 + EPI_ROW(0, m)) * D;
            *(u32x4*)(y + ro + pn * 256 + c8) = out0[m][0]; *(u32x4*)(y + ro + pn * 256 + 128 + c8) = out0[m][1];
            if (fq == 0) *(f32x2*)(part + ((size_t)(pn * 4 + wc) * M + row0 + EPI_ROW(0, m)) * 2) = st0[m]; }
#pragma unroll
        for (int m = 0; m < 4; ++m) { const size_t ro = (size_t)(row0 + EPI_ROW(1, m)) * D;
            *(u32x4*)(y + ro + pn * 256 + c8) = out1[m][0]; *(u32x4*)(y + ro + pn * 256 + 128 + c8) = out1[m][1];
            if (fq == 0) *(f32x2*)(part + ((size_t)(pn * 4 + wc) * M + row0 + EPI_ROW(1, m)) * 2) = st1[m]; }
    }
};
__device__ __forceinline__ u32x4 pair16(const u32x2 v0, const u32x2 v1, const bool odd) {
    const u32x2 keep = odd ? v1 : v0, send = odd ? v0 : v1; u32x2 recv; recv.x = __shfl_xor(send.x, 16); recv.y = __shfl_xor(send.y, 16);
    return odd ? (u32x4){recv.x, recv.y, keep.x, keep.y} : (u32x4){keep.x, keep.y, recv.x, recv.y};
}
struct Epi3 {
    unsigned char* __restrict__ hm; int row0, pn;
    __device__ __forceinline__ void run(const f32x4 (&acc)[2][2][4][2], int wr, int wc, int fr, int fq) const {
        const bool odd = fq & 1; const int cb = wc * 32 + 16 * (fq >> 1);
#pragma unroll
        for (int ai = 0; ai < 2; ++ai) {
            u32x2 v[4];
#pragma unroll
            for (int m = 0; m < 4; ++m) { float o[8];
#pragma unroll
                for (int j = 0; j < 4; ++j) { const float g0 = acc[ai][0][m][0][j] * 0.015625f, g1 = acc[ai][0][m][1][j] * 0.015625f; o[j] = clamp_fp8(g0 * sigmoidf_(g0) * (acc[ai][1][m][0][j] * 0.015625f)); o[4 + j] = clamp_fp8(g1 * sigmoidf_(g1) * (acc[ai][1][m][1][j] * 0.015625f)); }
                v[m] = (u32x2){pk4_fp8(o[0], o[1], o[2], o[3]), pk4_fp8(o[4], o[5], o[6], o[7])}; }
#pragma unroll
            for (int pr = 0; pr < 2; ++pr) { const u32x4 w = pair16(v[2 * pr], v[2 * pr + 1], odd); const int r = odd ? EPI_ROW(ai, 2 * pr + 1) : EPI_ROW(ai, 2 * pr);
                *(u32x4*)(hm + (size_t)(row0 + r) * FE + pn * 128 + cb) = w; }
        }
    }
};
#define EPI4_BODY(DD, WW) do { const bool odd = fq & 1; const int cb = wc * 32 + 16 * (fq >> 1); \
        _Pragma("unroll") for (int ai = 0; ai < 2; ++ai) \
            _Pragma("unroll") for (int pr = 0; pr < 2; ++pr) { int dd[2]; float ww[2]; u32x2 v[2][2]; \
                _Pragma("unroll") for (int mm = 0; mm < 2; ++mm) { const int r = EPI_ROW(ai, 2 * pr + mm); dd[mm] = DD; ww[mm] = WW; } \
                _Pragma("unroll") for (int mm = 0; mm < 2; ++mm) { const int m = 2 * pr + mm; const float w = ww[mm]; float o0[8], o1[8]; \
                    _Pragma("unroll") for (int j = 0; j < 4; ++j) { o0[j] = clamp_fp8(w * acc[ai][0][m][0][j]); o0[4 + j] = clamp_fp8(w * acc[ai][0][m][1][j]); o1[j] = clamp_fp8(w * acc[ai][1][m][0][j]); o1[4 + j] = clamp_fp8(w * acc[ai][1][m][1][j]); } \
                    v[0][mm] = (u32x2){pk4_fp8(o0[0], o0[1], o0[2], o0[3]), pk4_fp8(o0[4], o0[5], o0[6], o0[7])}; v[1][mm] = (u32x2){pk4_fp8(o1[0], o1[1], o1[2], o1[3]), pk4_fp8(o1[4], o1[5], o1[6], o1[7])}; } \
                const int d = odd ? dd[1] : dd[0]; \
                _Pragma("unroll") for (int h = 0; h < 2; ++h) { const u32x4 w4 = pair16(v[h][0], v[h][1], odd); if (d >= 0) *(u32x4*)(ct + (size_t)d * D + pn * 256 + h * 128 + cb) = w4; } } } while (0)
template <int AS> struct Epi4;
template <> struct Epi4<3> {
    unsigned char* __restrict__ ct; const LAS int* ld; const LAS float* lw; int pn;
    __device__ __forceinline__ void run(const f32x4 (&acc)[2][2][4][2], int wr, int wc, int fr, int fq) const { EPI4_BODY(ld[r], lw[r]); }
};
struct Epi4G {
    unsigned char* __restrict__ ct; const int* __restrict__ ld; const float* __restrict__ lw; int nvalid, pn;
    __device__ __forceinline__ void run(const f32x4 (&acc)[2][2][4][2], int wr, int wc, int fr, int fq) const { EPI4_BODY((r < nvalid ? ld[r] : -1), (r < nvalid ? lw[r] * 0.25f : 0.f)); }
};
#undef EPI_ROW

namespace pg8 {
constexpr int BM = 256, BK = 64, HALF = 128, HTB = HALF * BK * 2, STAGE_BYTES = 8 * HTB;
__device__ __forceinline__ int lds_byte(int r, int c) { const int st = (r >> 4) * 2 + (c >> 5), rr = r & 15, cc = c & 31, ob = rr * 64 + cc * 2; return st * 1024 + (ob ^ (((ob >> 9) & 1) << 5)); }
__device__ __forceinline__ void stage_rc(int b, int& R, int& C) { const int st = b / 1024, sb = b % 1024, swz = sb ^ (((sb >> 9) & 1) << 5); R = (st >> 1) * 16 + swz / 64; C = (st & 1) * 32 + (swz % 64) / 2; }
__device__ __forceinline__ int perm32(int rho) { const int n = rho >> 4, i = rho & 15; return 8 * (i >> 2) + 4 * n + (i & 3); }

typedef int i32x8 __attribute__((ext_vector_type(8)));
typedef unsigned u32x8 __attribute__((ext_vector_type(8)));
template <bool FP8> struct Frag;
template <> struct Frag<false> { u32x4 v[2]; };
template <> struct Frag<true> { i32x8 v; };
template <bool FP8> __device__ __forceinline__ Frag<FP8> ld_frag(const LAS unsigned char* p) {
    Frag<FP8> f;
    if constexpr (FP8) { const u32x4 a = *(const LAS u32x4*)p, b = *(const LAS u32x4*)(p + 16); f.v = __builtin_bit_cast(i32x8, __builtin_shufflevector(a, b, 0, 1, 2, 3, 4, 5, 6, 7)); }
    else { f.v[0] = *(const LAS u32x4*)p; f.v[1] = *(const LAS u32x4*)(p + 1024); }
    return f;
}
template <bool FP8> __device__ __forceinline__ f32x4 mma_frag(const Frag<FP8>& b, const Frag<FP8>& a, f32x4 acc) {
#if defined(__HIP_DEVICE_COMPILE__)
    if constexpr (FP8) { asm volatile("v_mfma_f32_16x16x128_f8f6f4 %0, %1, %2, %0" : "+v"(acc) : "v"(b.v), "v"(a.v)); return acc; }
#else
    if constexpr (FP8) return acc;
#endif
    else { acc = __builtin_amdgcn_mfma_f32_16x16x32_bf16(__builtin_bit_cast(bf16x8, b.v[0]), __builtin_bit_cast(bf16x8, a.v[0]), acc, 0, 0, 0);
           return __builtin_amdgcn_mfma_f32_16x16x32_bf16(__builtin_bit_cast(bf16x8, b.v[1]), __builtin_bit_cast(bf16x8, a.v[1]), acc, 0, 0, 0); }
}
template <class Prob, bool ALIGN_EPI, bool FP8 = false>
__device__ __forceinline__ void gemm_phase(LAS unsigned char* lds, const Prob& P, const int tid) {
    const int wid = __builtin_amdgcn_readfirstlane(tid >> 6), lane = tid & 63, wr = wid >> 2, wc = wid & 3, fr = lane & 15, fq = lane >> 4;
    const int K = P.K, RB = FP8 ? K : 2 * K, nt = RB / 128;
    unsigned voffB[2];
#pragma unroll
    for (int i = 0; i < 2; ++i) { int R, C; stage_rc(tid * 16 + i * 8192, R, C); const int Rb = (R & ~31) + perm32(R & 31); voffB[i] = (unsigned)(Rb * RB + C * 2); }
    const size_t kstep = (size_t)(BK * 2);
    const size_t hstepB = (size_t)HALF * RB;
    const unsigned ldsw = (unsigned)wid * 1024u;
    const int fcol = FP8 ? ((fq >> 1) * 32 + (fq & 1) * 16) : fq * 8;
    const int aoff = lds_byte(wr * 64 + fr, fcol), boff = lds_byte(wc * 32 + fr, fcol);
#define PG8_SA(b, h) (((b) * 2 + (h)) * HTB)
#define PG8_SB(b, h) ((4 + (b) * 2 + (h)) * HTB)
#define PG8_STAGE2(bufoff, gbase, o0, o1) do { \
        __builtin_amdgcn_global_load_lds((const unsigned*)((const char*)(gbase) + (o0)), (LAS unsigned*)(lds + (bufoff) + ldsw), 16, 0, 0); \
        __builtin_amdgcn_global_load_lds((const unsigned*)((const char*)(gbase) + (o1)), (LAS unsigned*)(lds + (bufoff) + ldsw + 8192), 16, 0, 0); } while (0)
#define PG8_STAGEB(bufoff, gbase) PG8_STAGE2(bufoff, gbase, voffB[0], voffB[1])
#define PG8_LDA(dst, b, h) do { _Pragma("unroll") for (int m = 0; m < 4; ++m) dst[m] = ld_frag<FP8>(lds + PG8_SA(b, h) + aoff + m * 2048); } while (0)
#define PG8_LDB(dst, b, h) do { _Pragma("unroll") for (int n = 0; n < 2; ++n) dst[n] = ld_frag<FP8>(lds + PG8_SB(b, h) + boff + n * 2048); } while (0)
#define PG8_MMA(ai, bj, At, Bt) do { __builtin_amdgcn_s_setprio(1); _Pragma("unroll") for (int m = 0; m < 4; ++m) _Pragma("unroll") for (int n = 0; n < 2; ++n) \
        acc[ai][bj][m][n] = mma_frag<FP8>(Bt[n], At[m], acc[ai][bj][m][n]); __builtin_amdgcn_s_setprio(0); } while (0)
#define PG8_WAIT_V(n) asm volatile("s_waitcnt vmcnt(" #n ")" ::: "memory")
#define PG8_WAIT_L(n) asm volatile("s_waitcnt lgkmcnt(" #n ")" ::: "memory")
#define PG8_BAR __builtin_amdgcn_s_barrier()
#define PG8_SCHED __builtin_amdgcn_sched_barrier(0)
    Unit cur, nxt; int ui = 0;
    if (!P.next(0, cur)) return;
    f32x4 acc[2][2][4][2];
#pragma unroll
    for (int a = 0; a < 2; ++a)
#pragma unroll
        for (int b = 0; b < 2; ++b)
#pragma unroll
            for (int m = 0; m < 4; ++m)
#pragma unroll
                for (int n = 0; n < 2; ++n) acc[a][b][m][n] = (f32x4){0.f, 0.f, 0.f, 0.f};
    Frag<FP8> At[4], B0[2], B1[2];
    const char* cA; const char* cB; unsigned c00, c01, c10, c11;
    P.resolve(cur, 0, cA, cB, c00, c01, c10, c11);
    PG8_STAGEB(PG8_SB(0, 0), cB); PG8_STAGEB(PG8_SB(0, 1), cB + hstepB); PG8_STAGE2(PG8_SA(0, 0), cA, c00, c01); PG8_STAGE2(PG8_SA(0, 1), cA, c10, c11);
    if (wr == 1) PG8_BAR;
    PG8_WAIT_V(2); PG8_BAR;
    PG8_STAGEB(PG8_SB(1, 0), cB + kstep); PG8_STAGE2(PG8_SA(1, 0), cA + kstep, c00, c01); PG8_STAGEB(PG8_SB(1, 1), cB + hstepB + kstep);
    PG8_WAIT_V(6); PG8_BAR;
    for (;;) {
        const bool has_next = P.next(ui + 1, nxt);
        const char* nA = cA; const char* nB = cB;
        if (has_next) { unsigned n00, n01, n10, n11; P.resolve(nxt, ui + 1, nA, nB, n00, n01, n10, n11); if constexpr (Prob::GATHER) *(LAS u32x4*)(lds + LDS_OFFS + tid * 16) = (u32x4){n00, n01, n10, n11}; }
        for (int t = 0; t < nt; t += 2) {
            const bool last = (t == nt - 2);
            const char* a1 = cA + (size_t)(t + 1) * kstep;
            const char* a2 = last ? nA : cA + (size_t)(t + 2) * kstep; const char* b2 = last ? nB : cB + (size_t)(t + 2) * kstep;
            const char* a3 = a2 + kstep; const char* b3 = b2 + kstep;
            PG8_LDB(B0, 0, 0); PG8_LDB(B1, 0, 1); PG8_SCHED; PG8_LDA(At, 0, 0); PG8_STAGE2(PG8_SA(1, 1), a1, c10, c11);
            if constexpr (Prob::GATHER) { if (last && has_next) { const u32x4 o = *(const LAS u32x4*)(lds + LDS_OFFS + tid * 16); c00 = o.x; c01 = o.y; c10 = o.z; c11 = o.w; } }
            PG8_WAIT_V(8); PG8_WAIT_L(0); PG8_BAR; PG8_MMA(0, 0, At, B0); PG8_MMA(0, 1, At, B1); PG8_BAR; PG8_SCHED;
            PG8_LDA(At, 0, 1); PG8_STAGEB(PG8_SB(0, 0), b2); PG8_STAGEB(PG8_SB(0, 1), b2 + hstepB); PG8_STAGE2(PG8_SA(0, 0), a2, c00, c01);
            PG8_WAIT_V(8); PG8_WAIT_L(0); PG8_BAR; PG8_MMA(1, 0, At, B0); PG8_MMA(1, 1, At, B1); PG8_BAR; PG8_SCHED;
            PG8_LDB(B0, 1, 0); PG8_LDB(B1, 1, 1); PG8_SCHED; PG8_LDA(At, 1, 0); PG8_STAGE2(PG8_SA(0, 1), a2, c10, c11);
            PG8_WAIT_V(8); PG8_WAIT_L(0); PG8_BAR; PG8_MMA(0, 0, At, B0); PG8_MMA(0, 1, At, B1); PG8_BAR; PG8_SCHED;
            PG8_LDA(At, 1, 1); PG8_STAGEB(PG8_SB(1, 0), b3); PG8_STAGEB(PG8_SB(1, 1), b3 + hstepB); PG8_STAGE2(PG8_SA(1, 0), a3, c00, c01);
            PG8_WAIT_V(8); PG8_WAIT_L(0); PG8_BAR; PG8_MMA(1, 0, At, B0); PG8_MMA(1, 1, At, B1); PG8_BAR; PG8_SCHED;
        }
        if constexpr (ALIGN_EPI) { if (wr == 0) PG8_BAR; }
        P.epi(cur, ui, acc, wr, wc, fr, fq);
        if (!has_next) break;
#pragma unroll
        for (int a = 0; a < 2; ++a)
#pragma unroll
            for (int b = 0; b < 2; ++b)
#pragma unroll
                for (int m = 0; m < 4; ++m)
#pragma unroll
                    for (int n = 0; n < 2; ++n) acc[a][b][m][n] = (f32x4){0.f, 0.f, 0.f, 0.f};
        cur = nxt; cA = nA; cB = nB; ++ui;
        if constexpr (ALIGN_EPI) { if (wr == 1) PG8_BAR; }
    }
    PG8_WAIT_V(0);
    if constexpr (!ALIGN_EPI) { if (wr == 0) PG8_BAR; }
    PG8_BAR;
#undef PG8_SA
#undef PG8_SB
#undef PG8_STAGE2
#undef PG8_STAGEB
#undef PG8_LDA
#undef PG8_LDB
#undef PG8_MMA
#undef PG8_WAIT_V
#undef PG8_WAIT_L
#undef PG8_BAR
#undef PG8_SCHED
}
__device__ __forceinline__ void lin_offsets(int tid, int RB, unsigned& o00, unsigned& o01, unsigned& o10, unsigned& o11) {
    int R0, C0, R1, C1; stage_rc(tid * 16, R0, C0); stage_rc(tid * 16 + 8192, R1, C1);
    o00 = (unsigned)(R0 * RB + C0 * 2); o01 = (unsigned)(R1 * RB + C1 * 2); o10 = (unsigned)((R0 + HALF) * RB + C0 * 2); o11 = (unsigned)((R1 + HALF) * RB + C1 * 2);
}
template <class E>
__device__ __forceinline__ void run_epi(const E& e, const f32x4 (&acc)[2][2][4][2], int wr, int wc, int fr, int fq) { e.run(acc, wr, wc, fr, fq); }
}

struct Frame { LAS unsigned char* lds; int tid, lane, wave, G, bid; };
extern __shared__ __attribute__((aligned(16))) unsigned char lds_raw[];
__device__ __forceinline__ Frame make_frame() { Frame F; int t = threadIdx.x; asm volatile("" : "+v"(t)); F.lds = (LAS unsigned char*)lds_raw; F.tid = t; F.lane = t & 63; F.wave = __builtin_amdgcn_readfirstlane(t >> 6); F.G = gridDim.x; F.bid = blockIdx.x; return F; }
typedef const __attribute__((address_space(4))) Args* KArgs;
__device__ __forceinline__ KArgs kargs_fresh() { KArgs p = (KArgs)__builtin_amdgcn_kernarg_segment_ptr(); asm volatile("" : "+s"(p)); return p; }


#define XB_TMO      128
#define XB_XCNT(j)  (256  + 64 * (j))
#define XB_XSUB(j)  (1280 + 64 * (j))
#define XB_XGEN(j)  (2304 + 64 * (j))
#define XB_TOP      3328
#define XB_TOPGEN   3392
#define XCD_BAR_WORDS 3456
#define XB_SPIN_CAP (1u << 18)
__device__ __forceinline__ unsigned xb_ld(unsigned* p)              { return __hip_atomic_load(p, __ATOMIC_RELAXED, __HIP_MEMORY_SCOPE_AGENT); }
__device__ __forceinline__ unsigned xb_add(unsigned* p, unsigned v) { return __hip_atomic_fetch_add(p, v, __ATOMIC_RELAXED, __HIP_MEMORY_SCOPE_AGENT); }
__device__ __forceinline__ unsigned xb_xcc_id() { return (unsigned)__builtin_amdgcn_s_getreg((3 << 11) | 20) & 0xFu; }
#define XB_SPIN(cond, bar) do { unsigned _sp = 0; while (cond) { __builtin_amdgcn_s_sleep(1); \
    if ((++_sp & 255u) == 0u) { if (xb_ld(&(bar)[XB_TMO])) break; if (_sp > XB_SPIN_CAP) { atomicAdd(&(bar)[XB_TMO], 1u); break; } } } } while (0)
struct XcdBarrier { unsigned* bar; unsigned x; volatile LAS unsigned* st; };
__device__ __forceinline__ XcdBarrier xcd_barrier_post(unsigned* bar, volatile LAS unsigned* st) {
    XcdBarrier b; b.bar = bar; b.x = xb_xcc_id(); b.st = st;
    if (threadIdx.x == 0) (void)xb_add(&bar[XB_XCNT(b.x)], 1u);
    return b;
}
__device__ __forceinline__ void xcd_barrier_complete(unsigned* bar, unsigned x, unsigned& nloc, unsigned& nx) {
    const unsigned G = gridDim.x * gridDim.y * gridDim.z;
    unsigned sum, cnt, mine, sp = 0u;
    for (;;) {
        sum = 0u; cnt = 0u; mine = 0u;
#pragma unroll
        for (unsigned j = 0; j < 16; ++j) { const unsigned c = xb_ld(&bar[XB_XCNT(j)]); sum += c; cnt += (c > 0u) ? 1u : 0u; mine = (j == x) ? c : mine; }
        if (sum == G) break;
        __builtin_amdgcn_s_sleep(1);
        if ((++sp & 255u) == 0u) { if (xb_ld(&bar[XB_TMO])) break; if (sp > XB_SPIN_CAP) { atomicAdd(&bar[XB_TMO], 1u); break; } }
    }
    nloc = mine > 0u ? mine : 1u; nx = cnt > 0u ? cnt : 1u;
}
__device__ __forceinline__ void xcd_barrier(const XcdBarrier& b) {
    asm volatile("s_waitcnt vmcnt(0)" ::: "memory");
    __syncthreads();
    if (threadIdx.x == 0) {
        unsigned* bar = b.bar;
        __builtin_amdgcn_s_waitcnt(0);
        unsigned nloc = b.st[0], nx = b.st[1];
        if (nloc == 0u) { xcd_barrier_complete(bar, b.x, nloc, nx); b.st[0] = nloc; b.st[1] = nx; }
        const unsigned old = xb_add(&bar[XB_XSUB(b.x)], 1u);
        const unsigned gen = old / nloc;
        if (old + 1u == (gen + 1u) * nloc) {
            __builtin_amdgcn_fence(__ATOMIC_RELEASE, "agent");
            asm volatile("s_waitcnt vmcnt(0)" ::: "memory");
            const unsigned og = xb_add(&bar[XB_TOP], 1u);
            const unsigned tg = og / nx;
            if (og + 1u == (tg + 1u) * nx) xb_add(&bar[XB_TOPGEN], 1u);
            else XB_SPIN(xb_ld(&bar[XB_TOPGEN]) == tg, bar);
            __builtin_amdgcn_fence(__ATOMIC_ACQUIRE, "agent");
            xb_add(&bar[XB_XGEN(b.x)], 1u);
            asm volatile("s_waitcnt vmcnt(0)" ::: "memory");
        } else {
            XB_SPIN(xb_ld(&bar[XB_XGEN(b.x)]) == gen, bar);
            __builtin_amdgcn_fence(__ATOMIC_ACQUIRE, "agent");
            asm volatile("s_waitcnt vmcnt(0)" ::: "memory");
        }
    }
    __syncthreads();
}

__device__ __forceinline__ int drow_map(int kind, int n) {
    if (kind == 0) return n;
    if (kind == 1) { if (n < 512) return ((n >> 7) << 8) + (n & 127); if (n < 1024) { const int c = n - 512; return ((c >> 7) << 8) + 128 + (c & 127); } return n; }
    if (kind == 2) return ((n >> 7) << 8) + (n & 127);
    return ((n >> 7) << 8) + 128 + (n & 127);
}
__device__ __forceinline__ void p0_transpose_item(const float* W, int N, bf16* WT, int Kd, int kind, int nblk, int item, LAS float* scr, int lane) {
    const int kb = item / nblk, nb = item % nblk, k0 = 64 * kb, n0 = 32 * nb;
#pragma unroll 8
    for (int i = 0; i < 32; ++i) { const int kk = 2 * i + (lane >> 5); scr[kk * 33 + (lane & 31)] = __builtin_nontemporal_load(W + (size_t)(k0 + kk) * N + n0 + (lane & 31)); }
    LDS_WAIT();
    const int c = lane & 7;
#pragma unroll
    for (int j = 0; j < 4; ++j) { const int n = (lane >> 3) + 8 * j; const LAS float* s = scr + (8 * c) * 33 + n;
        u32x4 o; o.x = pk2(s[0 * 33], s[1 * 33]); o.y = pk2(s[2 * 33], s[3 * 33]); o.z = pk2(s[4 * 33], s[5 * 33]); o.w = pk2(s[6 * 33], s[7 * 33]);
        *(u32x4*)(WT + (size_t)drow_map(kind, n0 + n) * Kd + k0 + 8 * c) = o; }
    LDS_WAIT();
}
__device__ __forceinline__ void p0_transpose_item_f8(const float* W, int N, unsigned char* WT, int Kd, int kind, int nblk, int item, LAS float* scr, int lane, const float wscale = 64.0f) {
    const int kb = item / nblk, nb = item % nblk, k0 = 64 * kb, n0 = 32 * nb;
#pragma unroll 8
    for (int i = 0; i < 32; ++i) { const int kk = 2 * i + (lane >> 5); scr[kk * 33 + (lane & 31)] = __builtin_nontemporal_load(W + (size_t)(k0 + kk) * N + n0 + (lane & 31)) * wscale; }
    LDS_WAIT();
    const int c = lane & 7;
#pragma unroll
    for (int j = 0; j < 4; ++j) { const int n = (lane >> 3) + 8 * j; const LAS float* s = scr + (8 * c) * 33 + n;
        *(u32x2*)(WT + (size_t)drow_map(kind, n0 + n) * Kd + k0 + 8 * c) = (u32x2){pk4_fp8(s[0 * 33], s[1 * 33], s[2 * 33], s[3 * 33]), pk4_fp8(s[4 * 33], s[5 * 33], s[6 * 33], s[7 * 33])}; }
    LDS_WAIT();
}
__device__ __forceinline__ void phase_p0a() {
    const Frame F = make_frame();
    const KArgs ka = kargs_fresh(); unsigned char* const ws = ka->ws;
    bf16* Win_t = (bf16*)(ws + WS_WIN); bf16* Wout_t = (bf16*)(ws + WS_WOUT); unsigned char* Wgu_t = ws + WS_WGU; unsigned char* Wd_t = ws + WS_WD;
    {
        LAS float* scr = (LAS float*)(F.lds + F.wave * 16384);
        const int gw = F.bid * NWAVES + F.wave, NGW = F.G * NWAVES;
        constexpr int N_EXP = 64 * 768, N_IN = 2 * 768, N_OUT = 2 * 256;
        for (int it = gw; it < N_EXP + N_IN + N_OUT; it += NGW) {
            if (it < N_EXP) {
                const int le = it / 768, r = it % 768;
                if (r < 256) p0_transpose_item_f8(ka->in[I_WG] + (size_t)le * D * FE, FE, Wgu_t + (size_t)le * D * D, D, 2, 16, r, scr, F.lane);
                else if (r < 512) p0_transpose_item_f8(ka->in[I_WU] + (size_t)le * D * FE, FE, Wgu_t + (size_t)le * D * D, D, 3, 16, r - 256, scr, F.lane);
                else p0_transpose_item_f8(ka->in[I_WDN] + (size_t)le * FE * D, D, Wd_t + (size_t)le * D * FE, FE, 0, 32, r - 512, scr, F.lane);
            } else if (it < N_EXP + N_IN) {
                const int r0 = it - N_EXP, l = r0 / 768, r = r0 % 768;
                p0_transpose_item_f8(ka->in[I_WIN] + (size_t)l * D * INW, INW, (unsigned char*)Win_t + (size_t)l * INW * D, D, 1, 48, r, scr, F.lane, 32.0f);
            } else {
                const int r0 = it - N_EXP - N_IN, l = r0 / 256, r = r0 % 256;
                p0_transpose_item_f8(ka->in[I_WOUT] + (size_t)l * D * D, D, (unsigned char*)Wout_t + (size_t)l * D * D, D, 0, 32, r, scr, F.lane, 64.0f);
            }
        }
    }
    __syncthreads();
    {
        LAS float* pws = (LAS float*)F.lds;
        LAS float* wo = (LAS float*)(F.lds + 128 * 129 * 4);
        for (int item = F.bid; item < 256; item += F.G) {
            const int l = item >> 7, g = (item >> 5) & 3, n0 = (item & 31) * 32;
            const float* pw = ka->in[I_POOLW] + (size_t)(l * 4 + g) * 128 * 128; const float* ps = ka->in[I_POOLS] + l * 512 + g * 128;
            const float* wout = ka->in[I_WOUT] + (size_t)l * D * D + (size_t)(512 + g * 128) * D;
            for (int i = 0; i < 32; ++i) { const int idx = F.tid + 512 * i, c = idx >> 7, d = idx & 127; pws[c * 129 + d] = pw[idx] * ps[d]; }
            for (int i = 0; i < 8; ++i) { const int idx = F.tid + 512 * i, d = idx >> 5, nn = idx & 31; wo[idx] = wout[(size_t)d * D + n0 + nn]; }
            __syncthreads();
            const int c = F.tid & 127, nq = F.tid >> 7;
            float acc[8];
#pragma unroll
            for (int i = 0; i < 8; ++i) acc[i] = 0.f;
#pragma unroll 1
            for (int d0 = 0; d0 < 128; d0 += 8) {
                float a[8]; f32x4 wl[8], wh[8];
#pragma unroll
                for (int dd = 0; dd < 8; ++dd) { a[dd] = pws[c * 129 + d0 + dd]; wl[dd] = *(const LAS f32x4*)(wo + (d0 + dd) * 32 + nq * 8); wh[dd] = *(const LAS f32x4*)(wo + (d0 + dd) * 32 + nq * 8 + 4); }
#pragma unroll
                for (int dd = 0; dd < 8; ++dd)
#pragma unroll
                    for (int i = 0; i < 4; ++i) { acc[i] += a[dd] * wl[dd][i]; acc[4 + i] += a[dd] * wh[dd][i]; }
            }
#pragma unroll
            for (int i = 0; i < 8; ++i) ((unsigned char*)Wout_t)[(size_t)l * D * D + (size_t)(n0 + nq * 8 + i) * D + 512 + g * 128 + c] = (unsigned char)(pk4_fp8(acc[i] * 64.0f, 0.f, 0.f, 0.f) & 0xffu);
            __syncthreads();
        }
    }
    {
        LAS float* cact = (LAS float*)F.lds;
        float* modp = (float*)(ws + WS_MODP);
        for (int item = F.bid; item < 384; item += F.G) {
            const int l = item / 192, r = item % 192, kc = r / 12, jc = r % 12, k0 = kc * 64, j = jc * 512 + F.tid;
            { const int b = F.tid >> 6, kk = F.tid & 63; const float cv = ka->in[I_C][b * D + k0 + kk]; cact[F.tid] = cv * sigmoidf_(cv); }
            __syncthreads();
            float acc[8];
#pragma unroll
            for (int b = 0; b < 8; ++b) acc[b] = 0.f;
            const float* wp = ka->in[I_WADA] + (size_t)l * D * 6 * D + (size_t)k0 * 6 * D + j;
#pragma unroll 8
            for (int kk = 0; kk < 64; ++kk) { const float w = __builtin_nontemporal_load(wp + (size_t)kk * 6 * D);
#pragma unroll
                for (int b = 0; b < 8; ++b) acc[b] += cact[b * 64 + kk] * w; }
#pragma unroll
            for (int b = 0; b < 8; ++b) modp[((size_t)(kc * L + l) * NB + b) * 6 * D + j] = acc[b];
            __syncthreads();
        }
    }
    {
        bf16* hi = (bf16*)(ws + WS_WR); bf16* lo = hi + NE * D;
        for (int idx = F.bid * NT + F.tid; idx < NE * D; idx += F.G * NT) { const int e = idx >> 10, k = idx & 1023; const float v = ka->in[I_WR][k * NE + e];
            const unsigned h = f2bf(v); hi[idx] = (bf16)h; lo[idx] = (bf16)f2bf(v - bflo(h)); }
    }
}

__device__ __forceinline__ float mod_sum(const float* modp, const float* bada, int l, int b, int j) {
    float s = bada[l * 6 * D + j];
#pragma unroll
    for (int kc = 0; kc < 16; ++kc) s += modp[((size_t)(kc * L + l) * NB + b) * 6 * D + j];
    return s;
}
__device__ __forceinline__ void phase_p0b() {
    const Frame F = make_frame();
    const KArgs ka = kargs_fresh(); unsigned char* const ws = ka->ws;
    float* mod = (float*)(ws + WS_MOD); const float* modp = (const float*)(ws + WS_MODP); const float* bada = ka->in[I_BADA];
    for (int idx = F.bid * NT + F.tid; idx < L * NB * 6 * D; idx += F.G * NT) { const int l = idx / (NB * 6 * D), rem = idx % (NB * 6 * D), b = rem / (6 * D), j = rem % (6 * D); mod[idx] = mod_sum(modp, bada, l, b, j); }
    LAS float* sh = (LAS float*)F.lds; LAS float* sc = sh + D;
    unsigned char* __restrict__ uq = ws + WS_A; bf16* __restrict__ xbo = (bf16*)(ws + WS_E);
    const float* __restrict__ xin = ka->in[I_X];
    for (int chunk = F.bid; chunk < M / 256; chunk += F.G) {
        const int b = chunk >> 5;
        __syncthreads();
        for (int i = F.tid; i < 2 * D; i += NT) { const float s = mod_sum(modp, bada, 0, b, i); if (i < D) sh[i] = s; else sc[i - D] = 1.0f + s; }
        __syncthreads();
#pragma unroll 2
        for (int rr = 0; rr < 32; ++rr) {
            const size_t row = (size_t)chunk * 256 + F.wave * 32 + rr;
            f32x4 xv[2][2];
#pragma unroll
            for (int h = 0; h < 2; ++h) { xv[h][0] = __builtin_nontemporal_load((const f32x4*)(xin + row * D + h * 512 + 8 * F.lane)); xv[h][1] = __builtin_nontemporal_load((const f32x4*)(xin + row * D + h * 512 + 8 * F.lane + 4)); }
#pragma unroll
            for (int h = 0; h < 2; ++h) { const int col = h * 512 + 8 * F.lane; float xs[8], uo[8];
#pragma unroll
                for (int q = 0; q < 2; ++q) { const f32x4 s1 = *(const LAS f32x4*)(sc + col + 4 * q), s0 = *(const LAS f32x4*)(sh + col + 4 * q);
#pragma unroll
                    for (int j = 0; j < 4; ++j) { xs[4 * q + j] = xv[h][q][j]; uo[4 * q + j] = xv[h][q][j] * s1[j] + s0[j]; } }
                *(u32x4*)(xbo + row * D + col) = pack8(xs);
                *(u32x2*)(uq + row * D + col) = (u32x2){pk4_fp8(uo[0], uo[1], uo[2], uo[3]), pk4_fp8(uo[4], uo[5], uo[6], uo[7])}; }
        }
    }
}

struct Prob1 {
    static constexpr bool GATHER = false;
    int tid;
    int K; StaticOrderC<M / 256, INW / 256> S; const char* A; const char* Bt; bf16* vp; const LAS float* b_in;
    __device__ __forceinline__ bool next(int i, Unit& u) const { return S.next(i, u); }
    __device__ __forceinline__ void resolve(const Unit& u, int, const char*& a, const char*& b, unsigned& o00, unsigned& o01, unsigned& o10, unsigned& o11) const {
        a = A + (size_t)u.pm * 256 * D; b = Bt + (size_t)u.pn * 256 * D; pg8::lin_offsets(tid, D, o00, o01, o10, o11); }
    __device__ __forceinline__ void epi(const Unit& u, int, const f32x4 (&acc)[2][2][4][2], int wr, int wc, int fr, int fq) const { const Epi1 E{vp, b_in, u.pm * 256, u.pn}; pg8::run_epi(E, acc, wr, wc, fr, fq); }
};
__device__ __forceinline__ void phase_gemm1(int l) {
    const Frame F = make_frame();
    const KArgs ka = kargs_fresh(); unsigned char* const ws = ka->ws;
    Prob1 P; P.tid = F.tid; P.K = D; P.S.init(M / 256, INW / 256, F.G, F.bid); P.A = (const char*)(ws + WS_A); P.Bt = (const char*)(ws + WS_WIN) + (size_t)l * INW * D; P.vp = (bf16*)(ws + WS_B);
    { LAS float* bl = (LAS float*)(F.lds + LDS_EPIC); const float* bg = ka->in[I_BIN] + l * INW; for (int i = F.tid; i < INW; i += NT) bl[i] = bg[i]; P.b_in = bl; __syncthreads(); }
    pg8::gemm_phase<Prob1, true, true>(F.lds, P, F.tid);
}

__device__ __forceinline__ void phase_convpool(int l) {
    const Frame F = make_frame();
    const KArgs ka = kargs_fresh(); unsigned char* const ws = ka->ws;
    const bf16* __restrict__ vp = (const bf16*)(ws + WS_B); bf16* __restrict__ A2 = (bf16*)(ws + WS_A);
    const float* cw = ka->in[I_CONVW] + l * CK * CW; const float* cb = ka->in[I_CONVB] + l * CW; const float* lg = ka->in[I_CLNG] + l * CW; const float* lb = ka->in[I_CLNB] + l * CW;
    LAS bf16* vin = (LAS bf16*)F.lds;
    LAS float* yo = (LAS float*)(F.lds + 63488);
    const int cp = F.tid & 255, rh = F.tid >> 8, chunk = F.tid & 63, prow = F.tid >> 6;
    h16x2 w2[CK];
#pragma unroll
    for (int j = 0; j < CK; ++j) w2[j] = __builtin_convertvector(*(const f32x2*)(cw + j * CW + 2 * cp), h16x2);
    const f32x2 cb2 = *(const f32x2*)(cb + 2 * cp);
    const f32x4 ga = *(const f32x4*)(lg + 8 * F.lane), gb = *(const f32x4*)(lg + 8 * F.lane + 4), ba = *(const f32x4*)(lb + 8 * F.lane), bb = *(const f32x4*)(lb + 8 * F.lane + 4);
    u32x4 vreg[8], preg[6];
#define CP_LOADV(tile_) do { const int row0_ = (tile_) * 32, t0_ = row0_ & (SEQ - 1); _Pragma("unroll") for (int pass = 0; pass < 8; ++pass) { const int r = pass * 8 + prow; vreg[pass] = (u32x4){0u, 0u, 0u, 0u}; \
        if (r < 62 && t0_ - 30 + r >= 0) vreg[pass] = *(const u32x4*)(vp + (size_t)(row0_ - 30 + r) * D + chunk * 8); } } while (0)
#define CP_LOADP(tile_) do { const int row0_ = (tile_) * 32, t0_ = row0_ & (SEQ - 1); _Pragma("unroll") for (int pass = 0; pass < 6; ++pass) { const int r = pass * 8 + prow; preg[pass] = (u32x4){0u, 0u, 0u, 0u}; \
        if (r < 47 && t0_ - 15 + r >= 0) preg[pass] = *(const u32x4*)(vp + (size_t)(row0_ - 15 + r) * D + 512 + chunk * 8); } } while (0)
    const bool owned = (F.G == M / 256);
    const int tstep = owned ? 1 : F.G, tend = owned ? 8 * F.bid + 8 : M / 32;
    int tile = owned ? 8 * F.bid : F.bid;
    if (tile < tend) CP_LOADV(tile);
#pragma unroll 1
    for (; tile < tend; tile += tstep) {
        const int row0 = tile * 32, t0 = row0 & (SEQ - 1);
#pragma unroll
        for (int pass = 0; pass < 8; ++pass) { const int r = pass * 8 + prow; if (r < 62) *(LAS u32x4*)(vin + r * 512 + chunk * 8) = vreg[pass]; }
        __syncthreads();
        if (tile + tstep < tend) CP_LOADV(tile + tstep);
        CP_LOADP(tile);
#pragma unroll 1
        for (int strip = 0; strip < 2; ++strip) {
            const int o0 = rh * 16 + strip * 8;
            h16x2 a2[8];
#pragma unroll
            for (int o = 0; o < 8; ++o) a2[o] = (h16x2){(_Float16)0.f, (_Float16)0.f};
            unsigned xr[38];
#pragma unroll
            for (int j = 0; j < 38; ++j) xr[j] = *(const LAS unsigned*)(vin + (o0 + j) * 512 + 2 * cp);
#pragma unroll
            for (int j = 0; j < 38; ++j) { const h16x2 x2 = __builtin_bit_cast(h16x2, xr[j]);
#pragma unroll
                for (int o = 0; o < 8; ++o) { const int tap = j - o; if (tap >= 0 && tap < CK) a2[o] += w2[tap] * x2; } }
#pragma unroll
            for (int o = 0; o < 8; ++o) *(LAS f32x2*)(yo + (o0 + o) * 512 + 2 * cp) = (f32x2){(float)a2[o].x + cb2.x, (float)a2[o].y + cb2.y};
        }
        __syncthreads();
#pragma unroll
        for (int pass = 0; pass < 6; ++pass) { const int r = pass * 8 + prow; if (r < 47) *(LAS u32x4*)(vin + r * 512 + chunk * 8) = preg[pass]; }
#pragma unroll 1
        for (int rr = 0; rr < 4; ++rr) { const int r = F.wave * 4 + rr;
            const f32x4 a = *(const LAS f32x4*)(yo + r * 512 + 8 * F.lane), b = *(const LAS f32x4*)(yo + r * 512 + 8 * F.lane + 4);
            const float mean = wave_sum((a[0] + a[1]) + (a[2] + a[3]) + (b[0] + b[1]) + (b[2] + b[3])) * (1.0f / 512.0f);
            const f32x4 da = a - mean, db = b - mean;
            const float var = wave_sum((da[0] * da[0] + da[1] * da[1]) + (da[2] * da[2] + da[3] * da[3]) + (db[0] * db[0] + db[1] * db[1]) + (db[2] * db[2] + db[3] * db[3])) * (1.0f / 512.0f);
            const float rstd = __builtin_amdgcn_rsqf(var + LN_EPS);
            float o[8];
#pragma unroll
            for (int j = 0; j < 4; ++j) { const float ya = da[j] * rstd * ga[j] + ba[j], yb = db[j] * rstd * gb[j] + bb[j]; o[j] = ya * sigmoidf_(ya); o[4 + j] = yb * sigmoidf_(yb); }
            *(u32x2*)((unsigned char*)A2 + (size_t)(row0 + r) * D + 8 * F.lane) = (u32x2){pk4_fp8(o[0], o[1], o[2], o[3]), pk4_fp8(o[4], o[5], o[6], o[7])};
        }
        __syncthreads();
        {
            const int w = 2 << (chunk >> 4), o0 = F.wave * 4;
            float sacc[8];
#pragma unroll
            for (int j = 0; j < 8; ++j) sacc[j] = 0.f;
#pragma unroll
            for (int i = 1; i < 16; ++i) { if (i < w) { float e[8]; unpack8(*(const LAS u32x4*)(vin + (o0 + 15 - i) * 512 + chunk * 8), e);
#pragma unroll
                    for (int j = 0; j < 8; ++j) sacc[j] += e[j]; } }
#pragma unroll
            for (int o = 0; o < 4; ++o) { const int li = o0 + o + 15; float cur[8]; unpack8(*(const LAS u32x4*)(vin + li * 512 + chunk * 8), cur);
                const int t = t0 + o0 + o; const float inv = __builtin_amdgcn_rcpf((float)((t + 1) < w ? (t + 1) : w)); float dd[8];
#pragma unroll
                for (int j = 0; j < 8; ++j) { sacc[j] += cur[j]; dd[j] = sacc[j] * inv - cur[j]; }
                *(u32x2*)((unsigned char*)A2 + (size_t)(row0 + o0 + o) * D + 512 + chunk * 8) = (u32x2){pk4_fp8(dd[0], dd[1], dd[2], dd[3]), pk4_fp8(dd[4], dd[5], dd[6], dd[7])};
                float old[8]; unpack8(*(const LAS u32x4*)(vin + (li - (w - 1)) * 512 + chunk * 8), old);
#pragma unroll
                for (int j = 0; j < 8; ++j) sacc[j] -= old[j]; }
        }
        __syncthreads();
    }
#undef CP_LOADV
#undef CP_LOADP
}

struct Prob2 {
    static constexpr bool GATHER = false;
    int tid;
    int K; StaticOrderC<M / 256, D / 256> S; const char* A; const char* Bt; bf16* y; const bf16* xb; const LAS float* bo; const LAS float* gg; float* part;
    __device__ __forceinline__ bool next(int i, Unit& u) const { return S.next(i, u); }
    __device__ __forceinline__ void resolve(const Unit& u, int, const char*& a, const char*& b, unsigned& o00, unsigned& o01, unsigned& o10, unsigned& o11) const {
        a = A + (size_t)u.pm * 256 * D; b = Bt + (size_t)u.pn * 256 * D; pg8::lin_offsets(tid, D, o00, o01, o10, o11); }
    __device__ __forceinline__ void epi(const Unit& u, int, const f32x4 (&acc)[2][2][4][2], int wr, int wc, int fr, int fq) const {
        const Epi2 E{y, xb, bo, gg, part, u.pm * 256, u.pn}; pg8::run_epi(E, acc, wr, wc, fr, fq); }
};
__device__ __forceinline__ void phase_gemm2(int l) {
    const Frame F = make_frame();
    const KArgs ka = kargs_fresh(); unsigned char* const ws = ka->ws;
    Prob2 P; P.tid = F.tid; P.K = D; P.S.init(M / 256, D / 256, F.G, F.bid); P.A = (const char*)(ws + WS_A); P.Bt = (const char*)(ws + WS_WOUT) + (size_t)l * D * D; P.y = (bf16*)(ws + WS_C);
    P.xb = (const bf16*)(ws + WS_E); P.part = (float*)(ws + WS_PART);
    {
        LAS float* bl = (LAS float*)(F.lds + LDS_EPIC); LAS float* gl = bl + D; const float* bg = ka->in[I_BOUT] + l * D; const float* gm = (const float*)(ws + WS_MOD) + (size_t)(l * NB + (F.bid >> 5)) * 6 * D + 2 * D;
        for (int i = F.tid; i < D; i += NT) { bl[i] = bg[i]; gl[i] = 1.0f + gm[i]; } P.bo = bl; P.gg = gl; __syncthreads(); }
    pg8::gemm_phase<Prob2, true, true>(F.lds, P, F.tid);
}

__device__ __forceinline__ void phase_ln1route(int l) {
    const Frame F = make_frame();
    const KArgs ka = kargs_fresh(); unsigned char* const ws = ka->ws;
    const bf16* __restrict__ y = (const bf16*)(ws + WS_C); unsigned char* __restrict__ u2q = ws + WS_A;
    const float* mod = (const float*)(ws + WS_MOD); float* stats = (float*)(ws + WS_STATS); const float* part = (const float*)(ws + WS_PART);
    const bf16* wr_hi = (const bf16*)(ws + WS_WR); const bf16* wr_lo = wr_hi + NE * D;
    unsigned* gcount = (unsigned*)(ws + WS_CTL) + CW_CNT + l * NE;
    int* listd = (int*)(ws + WS_LISTD); float* listw = (float*)(ws + WS_LISTW);
    LAS float* Pc = (LAS float*)F.lds; LAS float* Qc = Pc + D;
    LAS float* lgw = (LAS float*)(F.lds + 8192) + F.wave * 32 * 33;
    LAS int* lcnt = (LAS int*)(F.lds + 8192 + 8 * 32 * 33 * 4);
    LAS int* gbase = lcnt + 32;
    LAS int* asg_e = gbase + 32; LAS int* asg_r = asg_e + 512; LAS int* asg_d = asg_r + 512; LAS float* asg_w = (LAS float*)(asg_d + 512);
    const int fr = F.lane & 15, fq = F.lane >> 4;
    const float* rb = ka->in[I_RB];
    for (int chunk = F.bid; chunk < M / 256; chunk += F.G) {
        const int b = chunk >> 5;
        __syncthreads();
        for (int i = F.tid; i < D; i += NT) { const float g = ka->in[I_LN1G][l * D + i], bb = ka->in[I_LN1B][l * D + i];
            const float sc2 = 1.0f + mod[(size_t)(l * NB + b) * 6 * D + 4 * D + i], sh2 = mod[(size_t)(l * NB + b) * 6 * D + 3 * D + i];
            Pc[i] = g * sc2; Qc[i] = bb * sc2 + sh2; }
        if (F.tid < 32) lcnt[F.tid] = 0;
        __syncthreads();
        const int R0 = chunk * 256 + F.wave * 32;
        float mu[2], rs[2];
#pragma unroll
        for (int m = 0; m < 2; ++m) {
            const float* pp = part + ((size_t)(4 * fq) * M + R0 + 16 * m + fr) * 2;
            const f32x2 p0 = *(const f32x2*)pp, p1 = *(const f32x2*)(pp + (size_t)2 * M), p2 = *(const f32x2*)(pp + (size_t)4 * M), p3 = *(const f32x2*)(pp + (size_t)6 * M);
            float s = (p0.x + p1.x) + (p2.x + p3.x), q = (p0.y + p1.y) + (p2.y + p3.y);
            s += __shfl_xor(s, 16); s += __shfl_xor(s, 32); q += __shfl_xor(q, 16); q += __shfl_xor(q, 32);
            const float mean = s * (1.0f / D); float var = q * (1.0f / D) - mean * mean; var = var < 0.f ? 0.f : var;
            mu[m] = mean; rs[m] = __builtin_amdgcn_rsqf(var + LN_EPS);
            if (fq == 0) *(f32x2*)(stats + (size_t)(R0 + 16 * m + fr) * 2) = (f32x2){mean, rs[m]};
        }
        f32x4 acc[2][2];
#pragma unroll
        for (int m = 0; m < 2; ++m)
#pragma unroll
            for (int n = 0; n < 2; ++n) acc[m][n] = (f32x4){0.f, 0.f, 0.f, 0.f};
        const bf16* yr0 = y + (size_t)(R0 + fr) * D + 16 * fq; const bf16* yr1 = yr0 + (size_t)16 * D;
        unsigned char* ur0 = u2q + (size_t)(R0 + fr) * D + 16 * fq; unsigned char* ur1 = ur0 + (size_t)16 * D;
        const bf16* wh0 = wr_hi + (size_t)fr * D + 16 * fq; const bf16* wl0 = wr_lo + (size_t)fr * D + 16 * fq;
        u32x4 yc[2][2]; bf16x8 bhc[2][2], blc[2][2];
#pragma unroll
        for (int c = 0; c < 2; ++c) { yc[0][c] = *(const u32x4*)(yr0 + 8 * c); yc[1][c] = *(const u32x4*)(yr1 + 8 * c);
#pragma unroll
            for (int n = 0; n < 2; ++n) { bhc[n][c] = *(const bf16x8*)(wh0 + (size_t)n * 16 * D + 8 * c); blc[n][c] = *(const bf16x8*)(wl0 + (size_t)n * 16 * D + 8 * c); } }
#pragma unroll 1
        for (int it = 0; it < 16; ++it) {
            const int k = 64 * it + 16 * fq, kn = (it < 15) ? 64 * (it + 1) : 0;
            u32x4 yn[2][2]; bf16x8 bhn[2][2], bln[2][2];
#pragma unroll
            for (int c = 0; c < 2; ++c) { yn[0][c] = *(const u32x4*)(yr0 + kn + 8 * c); yn[1][c] = *(const u32x4*)(yr1 + kn + 8 * c);
#pragma unroll
                for (int n = 0; n < 2; ++n) { bhn[n][c] = *(const bf16x8*)(wh0 + (size_t)n * 16 * D + kn + 8 * c); bln[n][c] = *(const bf16x8*)(wl0 + (size_t)n * 16 * D + kn + 8 * c); } }
            float pc[16], qc[16];
#pragma unroll
            for (int c4 = 0; c4 < 4; ++c4) { const f32x4 pv = *(const LAS f32x4*)(Pc + k + 4 * c4), qv = *(const LAS f32x4*)(Qc + k + 4 * c4);
#pragma unroll
                for (int j = 0; j < 4; ++j) { pc[4 * c4 + j] = pv[j]; qc[4 * c4 + j] = qv[j]; } }
            bf16x8 ah[2][2], al[2][2];
#pragma unroll
            for (int m = 0; m < 2; ++m) {
                float uv[16];
#pragma unroll
                for (int c = 0; c < 2; ++c) { float e[8]; unpack8(yc[m][c], e);
#pragma unroll
                    for (int j = 0; j < 8; ++j) uv[8 * c + j] = (e[j] - mu[m]) * rs[m] * pc[8 * c + j] + qc[8 * c + j]; }
                *(u32x4*)((m ? ur1 : ur0) + 64 * it) = (u32x4){pk4_fp8(uv[0], uv[1], uv[2], uv[3]), pk4_fp8(uv[4], uv[5], uv[6], uv[7]), pk4_fp8(uv[8], uv[9], uv[10], uv[11]), pk4_fp8(uv[12], uv[13], uv[14], uv[15])};
#pragma unroll
                for (int c = 0; c < 2; ++c) { float h8[8], d8[8];
#pragma unroll
                    for (int j = 0; j < 8; ++j) h8[j] = uv[8 * c + j];
                    const u32x4 hv = pack8(h8); float hb[8]; unpack8(hv, hb);
#pragma unroll
                    for (int j = 0; j < 8; ++j) d8[j] = h8[j] - hb[j];
                    ah[m][c] = __builtin_bit_cast(bf16x8, hv); al[m][c] = __builtin_bit_cast(bf16x8, pack8(d8)); }
            }
#pragma unroll
            for (int c = 0; c < 2; ++c)
#pragma unroll
                for (int n = 0; n < 2; ++n)
#pragma unroll
                    for (int m = 0; m < 2; ++m) {
                        acc[m][n] = __builtin_amdgcn_mfma_f32_16x16x32_bf16(bhc[n][c], ah[m][c], acc[m][n], 0, 0, 0);
                        acc[m][n] = __builtin_amdgcn_mfma_f32_16x16x32_bf16(bhc[n][c], al[m][c], acc[m][n], 0, 0, 0);
                        acc[m][n] = __builtin_amdgcn_mfma_f32_16x16x32_bf16(blc[n][c], ah[m][c], acc[m][n], 0, 0, 0);
                    }
#pragma unroll
            for (int c = 0; c < 2; ++c) { yc[0][c] = yn[0][c]; yc[1][c] = yn[1][c];
#pragma unroll
                for (int n = 0; n < 2; ++n) { bhc[n][c] = bhn[n][c]; blc[n][c] = bln[n][c]; } }
        }
#pragma unroll
        for (int m = 0; m < 2; ++m)
#pragma unroll
            for (int n = 0; n < 2; ++n)
#pragma unroll
                for (int j = 0; j < 4; ++j) lgw[(16 * m + fr) * 33 + 16 * n + 4 * fq + j] = acc[m][n][j];
        LDS_WAIT();
        if (F.lane < 32) {
            float bestg = -1e30f; int be0 = 0, be1 = 0; float bs0 = 0.f, bs1 = 0.f;
#pragma unroll 1
            for (int g = 0; g < 4; ++g) {
                float m1 = -1e30f, m2 = -1e30f, s1 = 0.f, s2 = 0.f; int i1 = 0, i2 = 0;
#pragma unroll
                for (int i = 0; i < 8; ++i) { const int e = g * 8 + i; const float sc = sigmoidf_(lgw[F.lane * 33 + e]); const float sel = sc + rb[e];
                    if (sel > m1) { m2 = m1; i2 = i1; s2 = s1; m1 = sel; i1 = e; s1 = sc; } else if (sel > m2) { m2 = sel; i2 = e; s2 = sc; } }
                const float gs = m1 + m2;
                if (gs > bestg) { bestg = gs; be0 = i1; be1 = i2; bs0 = s1; bs1 = s2; }
            }
            const float inv = __builtin_amdgcn_rcpf(bs0 + bs1);
            const int tok = R0 + F.lane, slot = F.wave * 64 + F.lane * 2;
            const int r0 = atomicAdd((int*)&lcnt[be0], 1); const int r1 = atomicAdd((int*)&lcnt[be1], 1);
            asg_e[slot] = be0; asg_r[slot] = r0; asg_d[slot] = tok * 2; asg_w[slot] = bs0 * inv;
            asg_e[slot + 1] = be1; asg_r[slot + 1] = r1; asg_d[slot + 1] = tok * 2 + 1; asg_w[slot + 1] = bs1 * inv;
        }
        __syncthreads();
        if (F.tid < 32) gbase[F.tid] = (int)atomicAdd(&gcount[F.tid], (unsigned)lcnt[F.tid]);
        __syncthreads();
        { const int e = asg_e[F.tid], pos = gbase[e] + asg_r[F.tid]; listd[e * LISTCAP + pos] = asg_d[F.tid]; listw[e * LISTCAP + pos] = asg_w[F.tid]; }
    }
}

constexpr int LDS_ULIST = 131 * 1024;
constexpr int LDS_TILEE = 128 * 1024, LDS_TOFF = 132 * 1024, LDS_TABW = 134 * 1024, LDS_TAB = 145 * 1024, MOE_MAXU = 10;
__device__ __forceinline__ void moe_table(const Frame& F, const unsigned char* ws, int l, LAS int* toff, LAS int* ncnt, LAS int* tile_e) {
    const unsigned* gcount = (const unsigned*)(ws + WS_CTL) + CW_CNT + l * NE;
    __syncthreads();
    if (F.tid < NE) ncnt[F.tid] = (int)__hip_atomic_load(gcount + F.tid, __ATOMIC_RELAXED, __HIP_MEMORY_SCOPE_AGENT);
    __syncthreads();
    if (F.tid == 0) { int acc = 0; for (int e = 0; e < NE; ++e) { toff[e] = acc; acc += (ncnt[e] + 255) >> 8; } toff[NE] = acc; }
    __syncthreads();
    for (int pm = F.tid; pm < toff[NE]; pm += NT) { int e = 0; while (e < NE - 1 && toff[e + 1] <= pm) ++e; tile_e[pm] = e; }
    __syncthreads();
}

struct Prob3 {
    static constexpr bool GATHER = true;
    int tid;
    int K; StaticOrder S; const LAS int* toff; const LAS int* ncnt; const LAS int* tile_e; const LAS int* tab; const LAS int* ulist; const char* u2; const char* W; const int* listd; unsigned char* hm;
    __device__ __forceinline__ bool next(int i, Unit& u) const { if (i >= MOE_MAXU) return false; const int v = ulist[i]; u.pm = v >> 2; u.pn = v & 3; return v >= 0; }
    __device__ __forceinline__ void resolve(const Unit& u, int i, const char*& a, const char*& b, unsigned& o00, unsigned& o01, unsigned& o10, unsigned& o11) const {
        const int e = tile_e[u.pm];
        a = u2; b = W + (size_t)e * D * D + (size_t)u.pn * 256 * D;
        int R0, C0, R1, C1; pg8::stage_rc(tid * 16, R0, C0); pg8::stage_rc(tid * 16 + 8192, R1, C1);
        const LAS int* t = tab + i * 256; const int t00 = t[R0], t01 = t[R1], t10 = t[R0 + 128], t11 = t[R1 + 128];
        o00 = (unsigned)(t00 * D + C0 * 2); o01 = (unsigned)(t01 * D + C1 * 2); o10 = (unsigned)(t10 * D + C0 * 2); o11 = (unsigned)(t11 * D + C1 * 2);
    }
    __device__ __forceinline__ void epi(const Unit& u, int i, const f32x4 (&acc)[2][2][4][2], int wr, int wc, int fr, int fq) const { const Epi3 E{hm, u.pm * 256, u.pn}; pg8::run_epi(E, acc, wr, wc, fr, fq); }
};
struct Prob4 {
    static constexpr bool GATHER = false;
    int tid;
    int K; StaticOrder S; const LAS int* toff; const LAS int* ncnt; const LAS int* tile_e; const LAS int* tabd; const LAS float* tabw; const LAS int* ulist; const char* hm; const char* W; const int* listd; const float* listw; unsigned char* ct;
    __device__ __forceinline__ bool next(int i, Unit& u) const { if (i >= MOE_MAXU) return false; const int v = ulist[i]; u.pm = v >> 2; u.pn = v & 3; return v >= 0; }
    __device__ __forceinline__ void resolve(const Unit& u, int i, const char*& a, const char*& b, unsigned& o00, unsigned& o01, unsigned& o10, unsigned& o11) const {
        const int e = tile_e[u.pm];
        a = hm + (size_t)u.pm * 256 * FE; b = W + (size_t)e * D * FE + (size_t)u.pn * 256 * FE; pg8::lin_offsets(tid, FE, o00, o01, o10, o11); }
    __device__ __forceinline__ void epi(const Unit& u, int i, const f32x4 (&acc)[2][2][4][2], int wr, int wc, int fr, int fq) const {
        const Epi4<3> E{ct, tabd + i * 256, tabw + i * 256, u.pn}; pg8::run_epi(E, acc, wr, wc, fr, fq);
    }
};
__device__ __forceinline__ void phase_gemm3(int l) {
    const Frame F = make_frame();
    const KArgs ka = kargs_fresh(); unsigned char* const ws = ka->ws;
    LAS int* toff = (LAS int*)(F.lds + LDS_TOFF); LAS int* ncnt = toff + 40; LAS int* tile_e = (LAS int*)(F.lds + LDS_TILEE); LAS int* tab = (LAS int*)(F.lds + LDS_TAB);
    moe_table(F, ws, l, toff, ncnt, tile_e);
    Prob3 P; P.tid = F.tid; P.K = D; P.S.init(toff[NE], 4, F.G, F.bid); P.toff = toff; P.ncnt = ncnt; P.tile_e = tile_e; P.tab = tab; P.u2 = (const char*)(ws + WS_A); P.W = (const char*)(ws + WS_WGU) + (size_t)l * NE * D * D;
    P.listd = (const int*)(ws + WS_LISTD); P.hm = (unsigned char*)(ws + WS_B);
    { LAS int* ul = (LAS int*)(F.lds + LDS_ULIST); P.ulist = ul; if (F.tid < MOE_MAXU) { Unit u; ul[F.tid] = P.S.next(F.tid, u) ? (u.pm * 4 + u.pn) : -1; } __syncthreads(); }
    {
        const int r = F.tid & 255, i0 = F.tid >> 8; int v[MOE_MAXU / 2];
#pragma unroll
        for (int k = 0; k < MOE_MAXU / 2; ++k) { Unit u; v[k] = 0; if (P.next(i0 + 2 * k, u)) { const int e = tile_e[u.pm], ti = u.pm - toff[e]; if (r < ncnt[e] - ti * 256) v[k] = P.listd[e * LISTCAP + ti * 256 + r] >> 1; } }
#pragma unroll
        for (int k = 0; k < MOE_MAXU / 2; ++k) tab[(i0 + 2 * k) * 256 + r] = v[k];
        __syncthreads();
    }
    pg8::gemm_phase<Prob3, true, true>(F.lds, P, F.tid);
}
__device__ __forceinline__ void phase_gemm4(int l) {
    const Frame F = make_frame();
    const KArgs ka = kargs_fresh(); unsigned char* const ws = ka->ws;
    LAS int* toff = (LAS int*)(F.lds + LDS_TOFF); LAS int* ncnt = toff + 40; LAS int* tile_e = (LAS int*)(F.lds + LDS_TILEE); LAS int* tabd = (LAS int*)(F.lds + LDS_TAB); LAS float* tabw = (LAS float*)(F.lds + LDS_TABW);
    moe_table(F, ws, l, toff, ncnt, tile_e);
    Prob4 P; P.tid = F.tid; P.K = FE; P.S.init(toff[NE], 4, F.G, F.bid); P.toff = toff; P.ncnt = ncnt; P.tile_e = tile_e; P.tabd = tabd; P.tabw = tabw; P.hm = (const char*)(ws + WS_B); P.W = (const char*)(ws + WS_WD) + (size_t)l * NE * D * FE;
    P.listd = (const int*)(ws + WS_LISTD); P.listw = (const float*)(ws + WS_LISTW); P.ct = ws + WS_D;
    { LAS int* ul = (LAS int*)(F.lds + LDS_ULIST); P.ulist = ul; if (F.tid < MOE_MAXU) { Unit u; ul[F.tid] = P.S.next(F.tid, u) ? (u.pm * 4 + u.pn) : -1; } __syncthreads(); }
    {
        const int r = F.tid & 255, i0 = F.tid >> 8; int vd[MOE_MAXU / 2]; float vw[MOE_MAXU / 2];
#pragma unroll
        for (int k = 0; k < MOE_MAXU / 2; ++k) { Unit u; vd[k] = -1; vw[k] = 0.f; if (P.next(i0 + 2 * k, u)) { const int e = tile_e[u.pm], ti = u.pm - toff[e]; if (r < ncnt[e] - ti * 256) { vd[k] = P.listd[e * LISTCAP + ti * 256 + r]; vw[k] = P.listw[e * LISTCAP + ti * 256 + r] * 0.25f; } } }
#pragma unroll
        for (int k = 0; k < MOE_MAXU / 2; ++k) { tabd[(i0 + 2 * k) * 256 + r] = vd[k]; tabw[(i0 + 2 * k) * 256 + r] = vw[k]; }
        __syncthreads();
    }
    pg8::gemm_phase<Prob4, true, true>(F.lds, P, F.tid);
}

__device__ __forceinline__ void unpack_fp8x16(const u32x4 v, float (&e)[16]) {
#pragma unroll
    for (int q = 0; q < 4; ++q) { const unsigned w = v[q]; const f32x2 lo = __builtin_amdgcn_cvt_pk_f32_fp8(w, false), hi = __builtin_amdgcn_cvt_pk_f32_fp8(w, true); e[4 * q] = lo[0]; e[4 * q + 1] = lo[1]; e[4 * q + 2] = hi[0]; e[4 * q + 3] = hi[1]; }
}
__device__ __forceinline__ void phase_ln2(int l) {
    const Frame F = make_frame();
    const KArgs ka = kargs_fresh(); unsigned char* const ws = ka->ws;
    const bf16* __restrict__ y = (const bf16*)(ws + WS_C); const unsigned char* __restrict__ ct = ws + WS_D;
    const float* mod = (const float*)(ws + WS_MOD); const float* stats = (const float*)(ws + WS_STATS);
    bf16* __restrict__ x2 = (bf16*)(ws + WS_E); bf16* __restrict__ un = (bf16*)(ws + WS_A); float* __restrict__ outp = ka->out;
    const int gw = F.bid * NWAVES + F.wave, NGW = F.G * NWAVES, rpw = (M + NGW - 1) / NGW;
    const int r0 = gw * rpw, r1 = (r0 + rpw) < M ? (r0 + rpw) : M;
    const int c0 = 16 * F.lane;
    float ag[16], ab[16], g2v[16], b2v[16], mg[16], sc[16], sh[16];
#pragma unroll
    for (int q = 0; q < 4; ++q) { const f32x4 a = *(const f32x4*)(ka->in[I_LN1G] + l * D + c0 + 4 * q), b = *(const f32x4*)(ka->in[I_LN1B] + l * D + c0 + 4 * q), c = *(const f32x4*)(ka->in[I_LN2G] + l * D + c0 + 4 * q), d = *(const f32x4*)(ka->in[I_LN2B] + l * D + c0 + 4 * q);
#pragma unroll
        for (int j = 0; j < 4; ++j) { ag[4 * q + j] = ALPHA * a[j]; ab[4 * q + j] = ALPHA * b[j]; g2v[4 * q + j] = c[j]; b2v[4 * q + j] = d[j]; } }
    int bcur = -1;
    constexpr int RIF = 4;
#pragma unroll 1
    for (int row = r0; row < r1; row += RIF) {
        const int b = row >> 13;
        if (b != bcur) { bcur = b; const float* mb = mod + (size_t)(l * NB + b) * 6 * D; const float* mn = mod + (size_t)((l + 1 < L ? l + 1 : l) * NB + b) * 6 * D;
#pragma unroll
            for (int q = 0; q < 4; ++q) { const f32x4 a = *(const f32x4*)(mb + 5 * D + c0 + 4 * q), c = *(const f32x4*)(mn + D + c0 + 4 * q), d = *(const f32x4*)(mn + c0 + 4 * q);
#pragma unroll
                for (int j = 0; j < 4; ++j) { mg[4 * q + j] = (1.0f + a[j]) * 0.0625f; sc[4 * q + j] = 1.0f + c[j]; sh[4 * q + j] = d[j]; } } }
        u32x4 vy[RIF][2], v0[RIF], v1[RIF]; f32x2 st[RIF];
#pragma unroll
        for (int rr = 0; rr < RIF; ++rr) { const size_t r = (row + rr) < r1 ? (row + rr) : (r1 - 1); st[rr] = *(const f32x2*)(stats + r * 2);
            vy[rr][0] = __builtin_nontemporal_load((const u32x4*)(y + r * D + c0)); vy[rr][1] = __builtin_nontemporal_load((const u32x4*)(y + r * D + c0 + 8)); v0[rr] = __builtin_nontemporal_load((const u32x4*)(ct + (2 * r) * D + c0)); v1[rr] = __builtin_nontemporal_load((const u32x4*)(ct + (2 * r + 1) * D + c0)); }
#pragma unroll
        for (int rr = 0; rr < RIF; ++rr) {
            const size_t r = (row + rr) < r1 ? (row + rr) : (r1 - 1); const bool live = (row + rr) < r1;
            float z[16], e0[16], e1[16], ey[16]; float s = 0.f;
            { float t8[8]; unpack8(vy[rr][0], t8);
#pragma unroll
              for (int j = 0; j < 8; ++j) ey[j] = t8[j];
              unpack8(vy[rr][1], t8);
#pragma unroll
              for (int j = 0; j < 8; ++j) ey[8 + j] = t8[j]; }
            unpack_fp8x16(v0[rr], e0); unpack_fp8x16(v1[rr], e1);
#pragma unroll
            for (int j = 0; j < 16; ++j) { const float v = (ey[j] - st[rr].x) * st[rr].y * ag[j] + ab[j] + mg[j] * (e0[j] + e1[j]); z[j] = v; s += v; }
            const float mean = wave_sum(s) * (1.0f / D); float q = 0.f;
#pragma unroll
            for (int j = 0; j < 16; ++j) { z[j] -= mean; q += z[j] * z[j]; }
            const float rstd = __builtin_amdgcn_rsqf(wave_sum(q) * (1.0f / D) + LN_EPS);
            if (live) {
                float o[16];
#pragma unroll
                for (int j = 0; j < 16; ++j) o[j] = z[j] * rstd * g2v[j] + b2v[j];
                if (l == L - 1) {
#pragma unroll
                    for (int q4 = 0; q4 < 4; ++q4) *(f32x4*)(outp + r * D + c0 + 4 * q4) = (f32x4){o[4 * q4], o[4 * q4 + 1], o[4 * q4 + 2], o[4 * q4 + 3]};
                } else {
                    float uo[16];
#pragma unroll
                    for (int j = 0; j < 16; ++j) uo[j] = o[j] * sc[j] + sh[j];
#pragma unroll
                    for (int h = 0; h < 2; ++h) {
                        *(u32x4*)(x2 + r * D + c0 + 8 * h) = (u32x4){pk2(o[8 * h], o[8 * h + 1]), pk2(o[8 * h + 2], o[8 * h + 3]), pk2(o[8 * h + 4], o[8 * h + 5]), pk2(o[8 * h + 6], o[8 * h + 7])};
                        *(u32x2*)((unsigned char*)un + r * D + c0 + 8 * h) = (u32x2){pk4_fp8(uo[8 * h], uo[8 * h + 1], uo[8 * h + 2], uo[8 * h + 3]), pk4_fp8(uo[8 * h + 4], uo[8 * h + 5], uo[8 * h + 6], uo[8 * h + 7])}; }
                }
            }
        }
    }
}

constexpr int NPH = 2 + 7 * L;
#ifndef DUP
#define DUP -1
#endif
__global__ void __launch_bounds__(NT, 2) mk_fwd(Args args) {
    const int lo = args.ph_lo, hi = args.ph_hi;
    volatile LAS unsigned* misc = (volatile LAS unsigned*)((LAS unsigned char*)lds_raw + LDS_MISC);
    if (threadIdx.x < 16) misc[threadIdx.x] = 0u;
    __syncthreads();
    (void)xcd_barrier_post((unsigned*)(kargs_fresh()->ws + WS_CTL) + CW_BAR, misc);
#define IN(k) (lo <= (k) && (k) < hi)
#define SEAM(k) do { if (IN(k) && IN((k) + 1)) { XcdBarrier xb_; xb_.bar = (unsigned*)(kargs_fresh()->ws + WS_CTL) + CW_BAR; xb_.x = xb_xcc_id(); xb_.st = (volatile LAS unsigned*)((LAS unsigned char*)lds_raw + LDS_MISC); xcd_barrier(xb_); } } while (0)
    const bool owned = (gridDim.x == (unsigned)(M / 256));
#define LSEAM(k) do { if (IN(k) && IN((k) + 1)) { if (owned) { asm volatile("s_waitcnt vmcnt(0)" ::: "memory"); __syncthreads(); } else SEAM(k); } } while (0)
    if (IN(0)) { phase_p0a(); if (DUP == 0) phase_p0a(); }
    SEAM(0);
    if (IN(1)) { phase_p0b(); if (DUP == 1) phase_p0b(); }
    LSEAM(1);
#pragma unroll 1
    for (int l = 0; l < L; ++l) {
        const int pb = 2 + 7 * l;
        if (IN(pb + 0)) { phase_gemm1(l); if (DUP == 2) phase_gemm1(l); }
        SEAM(pb + 0);
        if (IN(pb + 1)) { phase_convpool(l); if (DUP == 3) phase_convpool(l); }
        LSEAM(pb + 1);
        if (IN(pb + 2)) { phase_gemm2(l); if (DUP == 4) phase_gemm2(l); }
        LSEAM(pb + 2);
        if (IN(pb + 3)) { phase_ln1route(l); if (DUP == 5) phase_ln1route(l); }
        SEAM(pb + 3);
        if (IN(pb + 4)) { phase_gemm3(l); if (DUP == 6) phase_gemm3(l); }
        SEAM(pb + 4);
        if (IN(pb + 5)) { phase_gemm4(l); if (DUP == 7) phase_gemm4(l); }
        SEAM(pb + 5);
        if (IN(pb + 6)) { phase_ln2(l); if (DUP == 8) phase_ln2(l); }
        LSEAM(pb + 6);
    }
#undef LSEAM
#undef SEAM
#undef IN
}

extern "C" void kernel_launch(void* const* d_in, const int* in_sizes, int n_in, void* d_out, int out_size, void* d_ws, size_t ws_size, hipStream_t stream) {
    static int grid = 0;
    if (grid == 0) {
        if (n_in != 23 || out_size != M * D || ws_size < WS_END) { fprintf(stderr, "kernel_launch: unexpected shapes (n_in %d out %d ws %zu)\n", n_in, out_size, ws_size); grid = -1; return; }
        int dev = 0, cus = 0;
        if (hipGetDevice(&dev) != hipSuccess || hipDeviceGetAttribute(&cus, hipDeviceAttributeMultiprocessorCount, dev) != hipSuccess) { grid = -1; return; }
        if (hipFuncSetAttribute((const void*)mk_fwd, hipFuncAttributeMaxDynamicSharedMemorySize, LDS_BYTES) != hipSuccess) { fprintf(stderr, "kernel_launch: hipFuncSetAttribute failed\n"); grid = -1; return; }
        int per_cu = 0;
        if (hipOccupancyMaxActiveBlocksPerMultiprocessor(&per_cu, (const void*)mk_fwd, NT, LDS_BYTES) != hipSuccess || per_cu < 1) { fprintf(stderr, "kernel_launch: occupancy query failed (%d)\n", per_cu); (void)hipGetLastError(); grid = -1; return; }
        if (cus != M / 256) { fprintf(stderr, "kernel_launch: built for a %d-CU device (one 256-row tile per workgroup); found %d CUs\n", M / 256, cus); grid = -1; return; }
        if (cus * MOE_MAXU < ((2 * M) / 256 + NE) * 4) { fprintf(stderr, "kernel_launch: %d CUs: more than MOE_MAXU MoE units per workgroup\n", cus); grid = -1; return; }
        grid = cus;
    }
    if (grid < 0) return;
    (void)hipMemsetAsync((char*)d_ws + WS_CTL, 0, CTL_ZERO_BYTES, stream);
    Args a{};
    for (int i = 0; i < 23; ++i) a.in[i] = (const float*)d_in[i];
    a.out = (float*)d_out; a.ws = (unsigned char*)d_ws; a.ph_lo = 0; a.ph_hi = NPH;
    void* kargs[] = {&a};
    const hipError_t e = hipLaunchCooperativeKernel((const void*)mk_fwd, dim3(grid), dim3(NT), kargs, LDS_BYTES, stream);
    if (e != hipSuccess) fprintf(stderr, "kernel_launch: cooperative launch failed: %s (grid %d)\n", hipGetErrorString(e), grid);
}
```

```cpp
#include <hip/hip_runtime.h>
#include <cstdio>
#include <cstdint>

#define GAS __attribute__((address_space(1)))
#define LAS __attribute__((address_space(3)))
typedef unsigned short bf16;
typedef short bf16x8 __attribute__((ext_vector_type(8)));
typedef float f32x4 __attribute__((ext_vector_type(4)));
typedef float f32x2 __attribute__((ext_vector_type(2)));
typedef unsigned u32x4 __attribute__((ext_vector_type(4)));
typedef unsigned u32x2 __attribute__((ext_vector_type(2)));

constexpr int NB = 8, SEQ = 8192, D = 1024, M = NB * SEQ, L = 2;
constexpr int CW = 512, INW = 1536, CK = 31, NE = 32, FE = 512;
constexpr float LN_EPS = 1e-5f;
constexpr float ALPHA = 1.4142135623730951f;
constexpr int NWAVES = 8, NT = 512;
constexpr int LDS_BYTES = 163840;
constexpr int LISTCAP = 65536;

constexpr size_t MiB = 1u << 20;
constexpr size_t WS_CTL = 0, CTL_ZERO_BYTES = 65536;
constexpr size_t WS_MOD = 1 * MiB;
constexpr size_t WS_MODP = 2 * MiB;
constexpr size_t WS_WR = 9 * MiB;
constexpr size_t WS_STATS = 10 * MiB;
constexpr size_t WS_LISTD = 12 * MiB;
constexpr size_t WS_LISTW = 20 * MiB;
constexpr size_t WS_WIN = 28 * MiB;
constexpr size_t WS_WOUT = 34 * MiB;
constexpr size_t WS_WGU = 38 * MiB;
constexpr size_t WS_WD = 166 * MiB;
constexpr size_t WS_A = 232 * MiB;
constexpr size_t WS_B = 360 * MiB;
constexpr size_t WS_C = 504 * MiB;
constexpr size_t WS_D = 632 * MiB;
constexpr size_t WS_E = 888 * MiB;
constexpr size_t WS_PART = 488 * MiB;
constexpr size_t WS_END = 1016 * MiB;
constexpr int CW_CNT = 64;
constexpr int CW_BAR = 1024;
constexpr int LDS_EPIC = 145 * 1024;
constexpr int LDS_OFFS = 134 * 1024;
constexpr int LDS_MISC = 133 * 1024;

#define LDS_WAIT() asm volatile("s_waitcnt lgkmcnt(0)" ::: "memory")
typedef __bf16 bf16v2 __attribute__((ext_vector_type(2)));
typedef _Float16 h16x2 __attribute__((ext_vector_type(2)));
__device__ __forceinline__ unsigned pk2h(float lo, float hi) { return __builtin_bit_cast(unsigned, __builtin_convertvector((f32x2){lo, hi}, h16x2)); }
__device__ __forceinline__ unsigned pk2(float lo, float hi) { return __builtin_bit_cast(unsigned, __builtin_convertvector((f32x2){lo, hi}, bf16v2)); }
__device__ __forceinline__ unsigned f2bf(float f) { return pk2(f, 0.f) & 0xffffu; }
__device__ __forceinline__ float bflo(unsigned u) { return __builtin_bit_cast(float, u << 16); }
__device__ __forceinline__ float bfhi(unsigned u) { return __builtin_bit_cast(float, u & 0xffff0000u); }
__device__ __forceinline__ float bf2f(bf16 b) { return __builtin_bit_cast(float, ((unsigned)b) << 16); }
__device__ __forceinline__ unsigned pk4_fp8(float a, float b, float c, float d) { unsigned r = __builtin_amdgcn_cvt_pk_fp8_f32(a, b, 0u, false); return __builtin_amdgcn_cvt_pk_fp8_f32(c, d, r, true); }
__device__ __forceinline__ float clamp_fp8(float x) { return __builtin_fminf(__builtin_fmaxf(x, -448.0f), 448.0f); }
__device__ __forceinline__ float fmac1(float acc, float a, float b) {
#if defined(__HIP_DEVICE_COMPILE__)
    asm("v_fmac_f32 %0, %1, %2" : "+v"(acc) : "v"(a), "v"(b));
#endif
    return acc;
}
__device__ __forceinline__ float sigmoidf_(float x) { return __builtin_amdgcn_rcpf(1.0f + __builtin_amdgcn_exp2f(x * -1.44269504089f)); }
__device__ __forceinline__ float wave_sum(float v) {
    v += __builtin_bit_cast(float, __builtin_amdgcn_update_dpp(0, __builtin_bit_cast(int, v), 0xB1, 0xf, 0xf, true));
    v += __builtin_bit_cast(float, __builtin_amdgcn_update_dpp(0, __builtin_bit_cast(int, v), 0x4E, 0xf, 0xf, true));
    v += __builtin_bit_cast(float, __builtin_amdgcn_update_dpp(0, __builtin_bit_cast(int, v), 0x141, 0xf, 0xf, true));
    v += __builtin_bit_cast(float, __builtin_amdgcn_update_dpp(0, __builtin_bit_cast(int, v), 0x140, 0xf, 0xf, true));
    const float a = __builtin_bit_cast(float, __builtin_amdgcn_readlane(__builtin_bit_cast(int, v), 0)), b = __builtin_bit_cast(float, __builtin_amdgcn_readlane(__builtin_bit_cast(int, v), 16));
    const float c = __builtin_bit_cast(float, __builtin_amdgcn_readlane(__builtin_bit_cast(int, v), 32)), d = __builtin_bit_cast(float, __builtin_amdgcn_readlane(__builtin_bit_cast(int, v), 48));
    return (a + b) + (c + d);
}

struct Args { const float* in[23]; float* out; unsigned char* ws; int ph_lo, ph_hi; };
enum { I_X = 0, I_C, I_WADA, I_BADA, I_WIN, I_BIN, I_CONVW, I_CONVB, I_CLNG, I_CLNB, I_POOLW, I_POOLS, I_WOUT, I_BOUT, I_LN1G, I_LN1B, I_WR, I_RB, I_WG, I_WU, I_WDN, I_LN2G, I_LN2B };

struct Unit { int pm, pn; };
struct StaticOrder {
    int nM, nN, nwg, G, c;
    __device__ void init(int nM_, int nN_, int G_, int c_) { nM = nM_; nN = nN_; nwg = nM * nN; G = G_; c = c_; }
    __device__ bool next(int i, Unit& u) const {
        const long Lq = (long)i * G + c; if (Lq >= nwg) return false;
        int wgid = (int)Lq; { const int q = nwg / 8, r = nwg % 8, xcd = wgid % 8, off = wgid / 8; wgid = (xcd < r ? xcd * (q + 1) : r * (q + 1) + (xcd - r) * q) + off; }
        const int nig = 8 * nN, gid = wgid / nig, fm = gid * 8, gsz = (nM - fm) < 8 ? (nM - fm) : 8;
        u.pm = fm + ((wgid % nig) % gsz); u.pn = (wgid % nig) / gsz; return true;
    }
};

template <int NM, int NN> struct StaticOrderC {
    int G, c;
    __device__ void init(int, int, int G_, int c_) { G = G_; c = c_; }
    __device__ __forceinline__ bool next(int i, Unit& u) const {
        if (G == NM) { u.pm = c; u.pn = i; return i < NN; }
        constexpr int nwg = NM * NN, q = nwg / 8, r = nwg % 8, nig = 8 * NN;
        const int Lq = i * G + c; if (Lq >= nwg) return false;
        const unsigned w0 = (unsigned)Lq, xcd = w0 % 8u, off = w0 / 8u; const unsigned wgid = (xcd < (unsigned)r ? xcd * (q + 1) : r * (q + 1) + (xcd - r) * q) + off;
        static_assert(NM % 8 == 0, "row-tile groups of 8");
        const unsigned gid = wgid / (unsigned)nig, fm = gid * 8u, rem = wgid % (unsigned)nig;
        u.pm = (int)(fm + rem % 8u); u.pn = (int)(rem / 8u); return true;
    }
};

__device__ __forceinline__ void unpack8(const u32x4 v, float (&e)[8]) { e[0] = bflo(v.x); e[1] = bfhi(v.x); e[2] = bflo(v.y); e[3] = bfhi(v.y); e[4] = bflo(v.z); e[5] = bfhi(v.z); e[6] = bflo(v.w); e[7] = bfhi(v.w); }
__device__ __forceinline__ u32x4 pack8(const float (&o)[8]) { return (u32x4){pk2(o[0], o[1]), pk2(o[2], o[3]), pk2(o[4], o[5]), pk2(o[6], o[7])}; }
#define EPI_ROW(ai, m) ((ai) * 128 + wr * 64 + (m) * 16 + fr)
struct Epi1 {
    bf16* __restrict__ vp; const LAS float* b_in; int row0, pn;
    __device__ __forceinline__ void run(const f32x4 (&acc)[2][2][4][2], int wr, int wc, int fr, int fq) const {
        const int c8 = wc * 32 + 8 * fq;
        if (pn < 4) {
            const int c = pn * 128 + c8; const f32x4 bal = *(const LAS f32x4*)(b_in + c), bah = *(const LAS f32x4*)(b_in + c + 4), bgl = *(const LAS f32x4*)(b_in + 512 + c), bgh = *(const LAS f32x4*)(b_in + 512 + c + 4);
#pragma unroll
            for (int ai = 0; ai < 2; ++ai)
#pragma unroll
                for (int m = 0; m < 4; ++m) { float o[8];
#pragma unroll
                    for (int j = 0; j < 4; ++j) { o[j] = (acc[ai][0][m][0][j] * 0.03125f + bal[j]) * sigmoidf_(acc[ai][1][m][0][j] * 0.03125f + bgl[j]); o[4 + j] = (acc[ai][0][m][1][j] * 0.03125f + bah[j]) * sigmoidf_(acc[ai][1][m][1][j] * 0.03125f + bgh[j]); }
                    *(u32x4*)(vp + (size_t)(row0 + EPI_ROW(ai, m)) * D + c) = (u32x4){pk2h(o[0], o[1]), pk2h(o[2], o[3]), pk2h(o[4], o[5]), pk2h(o[6], o[7])}; }
        } else {
            const int c = (pn - 4) * 256 + c8; const f32x4 b0l = *(const LAS f32x4*)(b_in + 1024 + c), b0h = *(const LAS f32x4*)(b_in + 1024 + c + 4), b1l = *(const LAS f32x4*)(b_in + 1152 + c), b1h = *(const LAS f32x4*)(b_in + 1152 + c + 4);
#pragma unroll
            for (int ai = 0; ai < 2; ++ai)
#pragma unroll
                for (int m = 0; m < 4; ++m) { float o0[8], o1[8];
#pragma unroll
                    for (int j = 0; j < 4; ++j) { o0[j] = acc[ai][0][m][0][j] * 0.03125f + b0l[j]; o0[4 + j] = acc[ai][0][m][1][j] * 0.03125f + b0h[j]; o1[j] = acc[ai][1][m][0][j] * 0.03125f + b1l[j]; o1[4 + j] = acc[ai][1][m][1][j] * 0.03125f + b1h[j]; }
                    bf16* rowp = vp + (size_t)(row0 + EPI_ROW(ai, m)) * D + 512 + c;
                    *(u32x4*)(rowp) = pack8(o0); *(u32x4*)(rowp + 128) = pack8(o1); }
        }
    }
};
struct Epi2 {
    bf16* __restrict__ y; const bf16* __restrict__ xb; const LAS float* bo; const LAS float* gg; float* __restrict__ part; int row0, pn;
    __device__ __forceinline__ void rows(const f32x4 (&acc)[2][2][4][2], const int ai, const u32x4 (&xr)[4][2], const int c8, u32x4 (&out)[4][2], f32x2 (&st)[4]) const {
#pragma unroll
        for (int m = 0; m < 4; ++m) { float s = 0.f, q = 0.f;
#pragma unroll
            for (int h = 0; h < 2; ++h) { const int c = pn * 256 + h * 128 + c8;
                const f32x4 b0 = *(const LAS f32x4*)(bo + c), b1 = *(const LAS f32x4*)(bo + c + 4), g0 = *(const LAS f32x4*)(gg + c), g1v = *(const LAS f32x4*)(gg + c + 4);
                float x8[8]; unpack8(xr[m][h], x8); float o[8];
#pragma unroll
                for (int j = 0; j < 4; ++j) { o[j] = ALPHA * x8[j] + g0[j] * (acc[ai][h][m][0][j] * 0.015625f + b0[j]); o[4 + j] = ALPHA * x8[4 + j] + g1v[j] * (acc[ai][h][m][1][j] * 0.015625f + b1[j]); }
                out[m][h] = pack8(o); float e[8]; unpack8(out[m][h], e);
#pragma unroll
                for (int j = 0; j < 8; ++j) { s += e[j]; q += e[j] * e[j]; } }
            st[m] = (f32x2){s, q}; }
#pragma unroll
        for (int m = 0; m < 4; ++m) { st[m].x += __shfl_xor(st[m].x, 16); st[m].y += __shfl_xor(st[m].y, 16); }
#pragma unroll
        for (int m = 0; m < 4; ++m) { st[m].x += __shfl_xor(st[m].x, 32); st[m].y += __shfl_xor(st[m].y, 32); }
    }
    __device__ __forceinline__ void run(const f32x4 (&acc)[2][2][4][2], int wr, int wc, int fr, int fq) const {
        const int c8 = wc * 32 + 8 * fq;
        u32x4 xr[4][2], xr1[4][2], out[4][2]; f32x2 st[4];
#pragma unroll
        for (int m = 0; m < 4; ++m)
#pragma unroll
            for (int h = 0; h < 2; ++h) xr[m][h] = __builtin_nontemporal_load((const u32x4*)(xb + (size_t)(row0 + EPI_ROW(0, m)) * D + pn * 256 + h * 128 + c8));
        rows(acc, 0, xr, c8, out, st);
#pragma unroll
        for (int m = 0; m < 4; ++m)
#pragma unroll
            for (int h = 0; h < 2; ++h) xr1[m][h] = __builtin_nontemporal_load((const u32x4*)(xb + (size_t)(row0 + EPI_ROW(1, m)) * D + pn * 256 + h * 128 + c8));
        asm volatile("" ::: "memory");
#pragma unroll
        for (int m = 0; m < 4; ++m) { const size_t ro = (size_t)(row0 + EPI_ROW(0, m)) * D;
            *(u32x4*)(y + ro + pn * 256 + c8) = out[m][0]; *(u32x4*)(y + ro + pn * 256 + 128 + c8) = out[m][1];
            if (fq == 0) *(f32x2*)(part + ((size_t)(pn * 4 + wc) * M + row0 + EPI_ROW(0, m)) * 2) = st[m]; }
        rows(acc, 1, xr1, c8, out, st);
#pragma unroll
        for (int m = 0; m < 4; ++m) { const size_t ro = (size_t)(row0 + EPI_ROW(1, m)) * D;
            *(u32x4*)(y + ro + pn * 256 + c8) = out[m][0]; *(u32x4*)(y + ro + pn * 256 + 128 + c8) = out[m][1];
            if (fq == 0) *(f32x2*)(part + ((size_t)(pn * 4 + wc) * M + row0 + EPI_ROW(1, m)) * 2) = st[m]; }
    }
};
__device__ __forceinline__ u32x4 pair16(const u32x2 v0, const u32x2 v1, const bool odd) {
    const u32x2 keep = odd ? v1 : v0, send = odd ? v0 : v1; u32x2 recv; recv.x = __shfl_xor(send.x, 16); recv.y = __shfl_xor(send.y, 16);
    return odd ? (u32x4){recv.x, recv.y, keep.x, keep.y} : (u32x4){keep.x, keep.y, recv.x, recv.y};
}
struct Epi3 {
    unsigned char* __restrict__ hm; int row0, pn;
    __device__ __forceinline__ void run(const f32x4 (&acc)[2][2][4][2], int wr, int wc, int fr, int fq) const {
        const bool odd = fq & 1; const int cb = wc * 32 + 16 * (fq >> 1);
#pragma unroll
        for (int ai = 0; ai < 2; ++ai) {
            u32x2 v[4];
#pragma unroll
            for (int m = 0; m < 4; ++m) { float o[8];
#pragma unroll
                for (int j = 0; j < 4; ++j) { const float g0 = acc[ai][0][m][0][j] * 0.015625f, g1 = acc[ai][0][m][1][j] * 0.015625f; o[j] = clamp_fp8(g0 * sigmoidf_(g0) * (acc[ai][1][m][0][j] * 0.015625f)); o[4 + j] = clamp_fp8(g1 * sigmoidf_(g1) * (acc[ai][1][m][1][j] * 0.015625f)); }
                v[m] = (u32x2){pk4_fp8(o[0], o[1], o[2], o[3]), pk4_fp8(o[4], o[5], o[6], o[7])}; }
#pragma unroll
            for (int pr = 0; pr < 2; ++pr) { const u32x4 w = pair16(v[2 * pr], v[2 * pr + 1], odd); const int r = odd ? EPI_ROW(ai, 2 * pr + 1) : EPI_ROW(ai, 2 * pr);
                *(u32x4*)(hm + (size_t)(row0 + r) * FE + pn * 128 + cb) = w; }
        }
    }
};
#define EPI4_BODY(DD, WW) do { const bool odd = fq & 1; const int cb = wc * 32 + 16 * (fq >> 1); \
        _Pragma("unroll") for (int ai = 0; ai < 2; ++ai) \
            _Pragma("unroll") for (int pr = 0; pr < 2; ++pr) { int dd[2]; float ww[2]; u32x2 v[2][2]; \
                _Pragma("unroll") for (int mm = 0; mm < 2; ++mm) { const int r = EPI_ROW(ai, 2 * pr + mm); dd[mm] = DD; ww[mm] = WW; } \
                _Pragma("unroll") for (int mm = 0; mm < 2; ++mm) { const int m = 2 * pr + mm; const float w = ww[mm]; float o0[8], o1[8]; \
                    _Pragma("unroll") for (int j = 0; j < 4; ++j) { o0[j] = clamp_fp8(w * acc[ai][0][m][0][j]); o0[4 + j] = clamp_fp8(w * acc[ai][0][m][1][j]); o1[j] = clamp_fp8(w * acc[ai][1][m][0][j]); o1[4 + j] = clamp_fp8(w * acc[ai][1][m][1][j]); } \
                    v[0][mm] = (u32x2){pk4_fp8(o0[0], o0[1], o0[2], o0[3]), pk4_fp8(o0[4], o0[5], o0[6], o0[7])}; v[1][mm] = (u32x2){pk4_fp8(o1[0], o1[1], o1[2], o1[3]), pk4_fp8(o1[4], o1[5], o1[6], o1[7])}; } \
                const int d = odd ? dd[1] : dd[0]; \
                _Pragma("unroll") for (int h = 0; h < 2; ++h) { const u32x4 w4 = pair16(v[h][0], v[h][1], odd); if (d >= 0) *(u32x4*)(ct + (size_t)d * D + pn * 256 + h * 128 + cb) = w4; } } } while (0)
template <int AS> struct Epi4;
template <> struct Epi4<3> {
    unsigned char* __restrict__ ct; const LAS int* ld; const LAS float* lw; int pn;
    __device__ __forceinline__ void run(const f32x4 (&acc)[2][2][4][2], int wr, int wc, int fr, int fq) const { EPI4_BODY(ld[r], lw[r]); }
};
struct Epi4G {
    unsigned char* __restrict__ ct; const int* __restrict__ ld; const float* __restrict__ lw; int nvalid, pn;
    __device__ __forceinline__ void run(const f32x4 (&acc)[2][2][4][2], int wr, int wc, int fr, int fq) const { EPI4_BODY((r < nvalid ? ld[r] : -1), (r < nvalid ? lw[r] * 0.25f : 0.f)); }
};
#undef EPI_ROW

namespace pg8 {
constexpr int BM = 256, BK = 64, HALF = 128, HTB = HALF * BK * 2, STAGE_BYTES = 8 * HTB;
__device__ __forceinline__ int lds_byte(int r, int c) { const int st = (r >> 4) * 2 + (c >> 5), rr = r & 15, cc = c & 31, ob = rr * 64 + cc * 2; return st * 1024 + (ob ^ (((ob >> 9) & 1) << 4)); }
__device__ __forceinline__ void stage_rc(int b, int& R, int& C) { const int st = b / 1024, sb = b % 1024, swz = sb ^ (((sb >> 9) & 1) << 4); R = (st >> 1) * 16 + swz / 64; C = (st & 1) * 32 + (swz % 64) / 2; }
__device__ __forceinline__ int perm32(int rho) { const int n = rho >> 4, i = rho & 15; return 8 * (i >> 2) + 4 * n + (i & 3); }

typedef int i32x8 __attribute__((ext_vector_type(8)));
typedef unsigned u32x8 __attribute__((ext_vector_type(8)));
template <bool FP8> struct Frag;
template <> struct Frag<false> { u32x4 v[2]; };
template <> struct Frag<true> { i32x8 v; };
template <bool FP8> __device__ __forceinline__ Frag<FP8> ld_frag(const LAS unsigned char* p, const LAS unsigned char* p2) {
    Frag<FP8> f;
    if constexpr (FP8) { const u32x4 a = *(const LAS u32x4*)p, b = *(const LAS u32x4*)p2; f.v = __builtin_bit_cast(i32x8, __builtin_shufflevector(a, b, 0, 1, 2, 3, 4, 5, 6, 7)); }
    else { f.v[0] = *(const LAS u32x4*)p; f.v[1] = *(const LAS u32x4*)(p + 1024); }
    return f;
}
template <bool FP8> __device__ __forceinline__ f32x4 mma_frag(const Frag<FP8>& b, const Frag<FP8>& a, f32x4 acc) {
#if defined(__HIP_DEVICE_COMPILE__)
    if constexpr (FP8) { asm volatile("v_mfma_f32_16x16x128_f8f6f4 %0, %1, %2, %0" : "+v"(acc) : "v"(b.v), "v"(a.v)); return acc; }
#else
    if constexpr (FP8) return acc;
#endif
    else { acc = __builtin_amdgcn_mfma_f32_16x16x32_bf16(__builtin_bit_cast(bf16x8, b.v[0]), __builtin_bit_cast(bf16x8, a.v[0]), acc, 0, 0, 0);
           return __builtin_amdgcn_mfma_f32_16x16x32_bf16(__builtin_bit_cast(bf16x8, b.v[1]), __builtin_bit_cast(bf16x8, a.v[1]), acc, 0, 0, 0); }
}
template <class Prob, bool ALIGN_EPI, bool FP8 = false>
__device__ __forceinline__ void gemm_phase(LAS unsigned char* lds, const Prob& P, const int tid) {
    const int wid = __builtin_amdgcn_readfirstlane(tid >> 6), lane = tid & 63, wr = wid >> 2, wc = wid & 3, fr = lane & 15, fq = lane >> 4;
    const int K = P.K, RB = FP8 ? K : 2 * K, nt = RB / 128;
    unsigned voffB[2];
#pragma unroll
    for (int i = 0; i < 2; ++i) { int R, C; stage_rc(tid * 16 + i * 8192, R, C); const int Rb = (R & ~31) + perm32(R & 31); voffB[i] = (unsigned)(Rb * RB + C * 2); }
    const size_t kstep = (size_t)(BK * 2);
    const size_t hstepB = (size_t)HALF * RB;
    const unsigned ldsw = (unsigned)wid * 1024u;
    const int fcol = FP8 ? ((fq >> 1) * 32 + (fq & 1) * 16) : fq * 8;
    const int aoff = lds_byte(wr * 64 + fr, fcol), boff = lds_byte(wc * 32 + fr, fcol), d16 = (fr & 8) ? -16 : 16;
#define PG8_SA(b, h) (((b) * 2 + (h)) * HTB)
#define PG8_SB(b, h) ((4 + (b) * 2 + (h)) * HTB)
#define PG8_STAGE2(bufoff, gbase, o0, o1) do { \
        __builtin_amdgcn_global_load_lds((const unsigned*)((const char*)(gbase) + (o0)), (LAS unsigned*)(lds + (bufoff) + ldsw), 16, 0, 0); \
        __builtin_amdgcn_global_load_lds((const unsigned*)((const char*)(gbase) + (o1)), (LAS unsigned*)(lds + (bufoff) + ldsw + 8192), 16, 0, 0); } while (0)
#define PG8_STAGEB(bufoff, gbase) PG8_STAGE2(bufoff, gbase, voffB[0], voffB[1])
#define PG8_STAGEA1(bufoff, gbase) do { if constexpr (Prob::GATHER) { PG8_STAGE2(bufoff, gbase, c10, c11); } else { PG8_STAGE2(bufoff, (gbase) + hstepA, c00, c01); } } while (0)
#define PG8_LDA(dst, b, h) do { _Pragma("unroll") for (int m = 0; m < 4; ++m) dst[m] = ld_frag<FP8>(lds + PG8_SA(b, h) + aoff + m * 2048, lds + PG8_SA(b, h) + aoff + m * 2048 + d16); } while (0)
#define PG8_LDB(dst, b, h) do { _Pragma("unroll") for (int n = 0; n < 2; ++n) dst[n] = ld_frag<FP8>(lds + PG8_SB(b, h) + boff + n * 2048, lds + PG8_SB(b, h) + boff + n * 2048 + d16); } while (0)
#define PG8_MMA(ai, bj, At, Bt) do { __builtin_amdgcn_s_setprio(1); _Pragma("unroll") for (int m = 0; m < 4; ++m) _Pragma("unroll") for (int n = 0; n < 2; ++n) \
        acc[ai][bj][m][n] = mma_frag<FP8>(Bt[n], At[m], acc[ai][bj][m][n]); __builtin_amdgcn_s_setprio(0); } while (0)
#define PG8_WAIT_V(n) asm volatile("s_waitcnt vmcnt(" #n ")" ::: "memory")
#define PG8_WAIT_L(n) asm volatile("s_waitcnt lgkmcnt(" #n ")" ::: "memory")
#define PG8_BAR __builtin_amdgcn_s_barrier()
#define PG8_SCHED __builtin_amdgcn_sched_barrier(0)
    Unit cur, nxt; int ui = 0;
    if (!P.next(0, cur)) return;
    f32x4 acc[2][2][4][2];
#pragma unroll
    for (int a = 0; a < 2; ++a)
#pragma unroll
        for (int b = 0; b < 2; ++b)
#pragma unroll
            for (int m = 0; m < 4; ++m)
#pragma unroll
                for (int n = 0; n < 2; ++n) acc[a][b][m][n] = (f32x4){0.f, 0.f, 0.f, 0.f};
    Frag<FP8> At[4], B0[2], B1[2];
    const size_t hstepA = Prob::GATHER ? (size_t)0 : (size_t)HALF * RB;
    const char* cA; const char* cB; unsigned c00, c01, c10, c11;
    P.resolve(cur, 0, cA, cB, c00, c01, c10, c11);
    PG8_STAGEB(PG8_SB(0, 0), cB); PG8_STAGEB(PG8_SB(0, 1), cB + hstepB); PG8_STAGE2(PG8_SA(0, 0), cA, c00, c01); PG8_STAGEA1(PG8_SA(0, 1), cA);
    if (wr == 1) PG8_BAR;
    PG8_WAIT_V(2); PG8_BAR;
    PG8_STAGEB(PG8_SB(1, 0), cB + kstep); PG8_STAGE2(PG8_SA(1, 0), cA + kstep, c00, c01); PG8_STAGEB(PG8_SB(1, 1), cB + hstepB + kstep);
    PG8_WAIT_V(6); PG8_BAR;
    for (;;) {
        const bool has_next = P.next(ui + 1, nxt);
        const char* nA = cA; const char* nB = cB;
        if (has_next) { unsigned n00, n01, n10, n11; P.resolve(nxt, ui + 1, nA, nB, n00, n01, n10, n11); if constexpr (Prob::GATHER) *(LAS u32x4*)(lds + LDS_OFFS + tid * 16) = (u32x4){n00, n01, n10, n11}; }
        for (int t = 0; t < nt; t += 2) {
            const bool last = (t == nt - 2);
            const char* a1 = cA + (size_t)(t + 1) * kstep;
            const char* a2 = last ? nA : cA + (size_t)(t + 2) * kstep; const char* b2 = last ? nB : cB + (size_t)(t + 2) * kstep;
            const char* a3 = a2 + kstep; const char* b3 = b2 + kstep;
            PG8_LDB(B0, 0, 0); PG8_LDB(B1, 0, 1); PG8_SCHED; PG8_LDA(At, 0, 0); PG8_STAGEA1(PG8_SA(1, 1), a1);
            if constexpr (Prob::GATHER) { if (last && has_next) { const u32x4 o = *(const LAS u32x4*)(lds + LDS_OFFS + tid * 16); c00 = o.x; c01 = o.y; c10 = o.z; c11 = o.w; } }
            PG8_WAIT_V(8); PG8_WAIT_L(0); PG8_BAR; PG8_MMA(0, 0, At, B0); PG8_MMA(0, 1, At, B1); PG8_BAR; PG8_SCHED;
            PG8_LDA(At, 0, 1); PG8_STAGEB(PG8_SB(0, 0), b2); PG8_STAGEB(PG8_SB(0, 1), b2 + hstepB); PG8_STAGE2(PG8_SA(0, 0), a2, c00, c01);
            PG8_WAIT_V(8); PG8_WAIT_L(0); PG8_BAR; PG8_MMA(1, 0, At, B0); PG8_MMA(1, 1, At, B1); PG8_BAR; PG8_SCHED;
            PG8_LDB(B0, 1, 0); PG8_LDB(B1, 1, 1); PG8_SCHED; PG8_LDA(At, 1, 0); PG8_STAGEA1(PG8_SA(0, 1), a2);
            PG8_WAIT_V(8); PG8_WAIT_L(0); PG8_BAR; PG8_MMA(0, 0, At, B0); PG8_MMA(0, 1, At, B1); PG8_BAR; PG8_SCHED;
            PG8_LDA(At, 1, 1); PG8_STAGEB(PG8_SB(1, 0), b3); PG8_STAGEB(PG8_SB(1, 1), b3 + hstepB); PG8_STAGE2(PG8_SA(1, 0), a3, c00, c01);
            PG8_WAIT_V(8); PG8_WAIT_L(0); PG8_BAR; PG8_MMA(1, 0, At, B0); PG8_MMA(1, 1, At, B1); PG8_BAR; PG8_SCHED;
        }
        if constexpr (ALIGN_EPI) { if (wr == 0) PG8_BAR; }
        P.epi(cur, ui, acc, wr, wc, fr, fq);
        if (!has_next) break;
#pragma unroll
        for (int a = 0; a < 2; ++a)
#pragma unroll
            for (int b = 0; b < 2; ++b)
#pragma unroll
                for (int m = 0; m < 4; ++m)
#pragma unroll
                    for (int n = 0; n < 2; ++n) acc[a][b][m][n] = (f32x4){0.f, 0.f, 0.f, 0.f};
        cur = nxt; cA = nA; cB = nB; ++ui;
        if constexpr (ALIGN_EPI) { if (wr == 1) PG8_BAR; }
    }
    PG8_WAIT_V(0);
    if constexpr (!ALIGN_EPI) { if (wr == 0) PG8_BAR; }
    PG8_BAR;
#undef PG8_STAGEA1
#undef PG8_SA
#undef PG8_SB
#undef PG8_STAGE2
#undef PG8_STAGEB
#undef PG8_LDA
#undef PG8_LDB
#undef PG8_MMA
#undef PG8_WAIT_V
#undef PG8_WAIT_L
#undef PG8_BAR
#undef PG8_SCHED
}
__device__ __forceinline__ void lin_offsets(int tid, int RB, unsigned& o00, unsigned& o01, unsigned& o10, unsigned& o11) {
    int R0, C0, R1, C1; stage_rc(tid * 16, R0, C0); stage_rc(tid * 16 + 8192, R1, C1);
    o00 = (unsigned)(R0 * RB + C0 * 2); o01 = (unsigned)(R1 * RB + C1 * 2); o10 = (unsigned)((R0 + HALF) * RB + C0 * 2); o11 = (unsigned)((R1 + HALF) * RB + C1 * 2);
}
template <class E>
__device__ __forceinline__ void run_epi(const E& e, const f32x4 (&acc)[2][2][4][2], int wr, int wc, int fr, int fq) { e.run(acc, wr, wc, fr, fq); }
}

struct Frame { LAS unsigned char* lds; int tid, lane, wave, G, bid; };
extern __shared__ __attribute__((aligned(16))) unsigned char lds_raw[];
__device__ __forceinline__ Frame make_frame() { Frame F; int t = threadIdx.x; asm volatile("" : "+v"(t)); F.lds = (LAS unsigned char*)lds_raw; F.tid = t; F.lane = t & 63; F.wave = __builtin_amdgcn_readfirstlane(t >> 6); F.G = gridDim.x; F.bid = blockIdx.x; return F; }
typedef const __attribute__((address_space(4))) Args* KArgs;
__device__ __forceinline__ KArgs kargs_fresh() { KArgs p = (KArgs)__builtin_amdgcn_kernarg_segment_ptr(); asm volatile("" : "+s"(p)); return p; }


#define XB_TMO      128
#define XB_XCNT(j)  (256  + 64 * (j))
#define XB_XSUB(j)  (1280 + 64 * (j))
#define XB_XGEN(j)  (2304 + 64 * (j))
#define XB_TOP      3328
#define XB_TOPGEN   3392
#define XCD_BAR_WORDS 3456
#define XB_SPIN_CAP (1u << 18)
__device__ __forceinline__ unsigned xb_ld(unsigned* p)              { return __hip_atomic_load(p, __ATOMIC_RELAXED, __HIP_MEMORY_SCOPE_AGENT); }
__device__ __forceinline__ unsigned xb_add(unsigned* p, unsigned v) { return __hip_atomic_fetch_add(p, v, __ATOMIC_RELAXED, __HIP_MEMORY_SCOPE_AGENT); }
__device__ __forceinline__ unsigned xb_xcc_id() { return (unsigned)__builtin_amdgcn_s_getreg((3 << 11) | 20) & 0xFu; }
#define XB_SPIN(cond, bar) do { unsigned _sp = 0; while (cond) { __builtin_amdgcn_s_sleep(1); \
    if ((++_sp & 255u) == 0u) { if (xb_ld(&(bar)[XB_TMO])) break; if (_sp > XB_SPIN_CAP) { atomicAdd(&(bar)[XB_TMO], 1u); break; } } } } while (0)
struct XcdBarrier { unsigned* bar; unsigned x; volatile LAS unsigned* st; };
__device__ __forceinline__ XcdBarrier xcd_barrier_post(unsigned* bar, volatile LAS unsigned* st) {
    XcdBarrier b; b.bar = bar; b.x = xb_xcc_id(); b.st = st;
    if (threadIdx.x == 0) (void)xb_add(&bar[XB_XCNT(b.x)], 1u);
    return b;
}
__device__ __forceinline__ void xcd_barrier_complete(unsigned* bar, unsigned x, unsigned& nloc, unsigned& nx) {
    const unsigned G = gridDim.x * gridDim.y * gridDim.z;
    unsigned sum, cnt, mine, sp = 0u;
    for (;;) {
        sum = 0u; cnt = 0u; mine = 0u;
#pragma unroll
        for (unsigned j = 0; j < 16; ++j) { const unsigned c = xb_ld(&bar[XB_XCNT(j)]); sum += c; cnt += (c > 0u) ? 1u : 0u; mine = (j == x) ? c : mine; }
        if (sum == G) break;
        __builtin_amdgcn_s_sleep(1);
        if ((++sp & 255u) == 0u) { if (xb_ld(&bar[XB_TMO])) break; if (sp > XB_SPIN_CAP) { atomicAdd(&bar[XB_TMO], 1u); break; } }
    }
    nloc = mine > 0u ? mine : 1u; nx = cnt > 0u ? cnt : 1u;
}
__device__ __forceinline__ void xcd_barrier(const XcdBarrier& b) {
    asm volatile("s_waitcnt vmcnt(0)" ::: "memory");
    __syncthreads();
    if (threadIdx.x == 0) {
        unsigned* bar = b.bar;
        __builtin_amdgcn_s_waitcnt(0);
        unsigned nloc = b.st[0], nx = b.st[1];
        if (nloc == 0u) { xcd_barrier_complete(bar, b.x, nloc, nx); b.st[0] = nloc; b.st[1] = nx; }
        const unsigned old = xb_add(&bar[XB_XSUB(b.x)], 1u);
        const unsigned gen = old / nloc;
        if (old + 1u == (gen + 1u) * nloc) {
            __builtin_amdgcn_fence(__ATOMIC_RELEASE, "agent");
            asm volatile("s_waitcnt vmcnt(0)" ::: "memory");
            const unsigned og = xb_add(&bar[XB_TOP], 1u);
            const unsigned tg = og / nx;
            if (og + 1u == (tg + 1u) * nx) xb_add(&bar[XB_TOPGEN], 1u);
            else XB_SPIN(xb_ld(&bar[XB_TOPGEN]) == tg, bar);
            __builtin_amdgcn_fence(__ATOMIC_ACQUIRE, "agent");
            xb_add(&bar[XB_XGEN(b.x)], 1u);
            asm volatile("s_waitcnt vmcnt(0)" ::: "memory");
        } else {
            XB_SPIN(xb_ld(&bar[XB_XGEN(b.x)]) == gen, bar);
            __builtin_amdgcn_fence(__ATOMIC_ACQUIRE, "agent");
            asm volatile("s_waitcnt vmcnt(0)" ::: "memory");
        }
    }
    __syncthreads();
}

__device__ __forceinline__ int drow_map(int kind, int n) {
    if (kind == 0) return n;
    if (kind == 1) { if (n < 512) return ((n >> 7) << 8) + (n & 127); if (n < 1024) { const int c = n - 512; return ((c >> 7) << 8) + 128 + (c & 127); } return n; }
    if (kind == 2) return ((n >> 7) << 8) + (n & 127);
    return ((n >> 7) << 8) + 128 + (n & 127);
}
__device__ __forceinline__ void p0_transpose_item(const float* W, int N, bf16* WT, int Kd, int kind, int nblk, int item, LAS float* scr, int lane) {
    const int kb = item / nblk, nb = item % nblk, k0 = 64 * kb, n0 = 32 * nb;
#pragma unroll 8
    for (int i = 0; i < 32; ++i) { const int kk = 2 * i + (lane >> 5); scr[kk * 33 + (lane & 31)] = __builtin_nontemporal_load(W + (size_t)(k0 + kk) * N + n0 + (lane & 31)); }
    LDS_WAIT();
    const int c = lane & 7;
#pragma unroll
    for (int j = 0; j < 4; ++j) { const int n = (lane >> 3) + 8 * j; const LAS float* s = scr + (8 * c) * 33 + n;
        u32x4 o; o.x = pk2(s[0 * 33], s[1 * 33]); o.y = pk2(s[2 * 33], s[3 * 33]); o.z = pk2(s[4 * 33], s[5 * 33]); o.w = pk2(s[6 * 33], s[7 * 33]);
        *(u32x4*)(WT + (size_t)drow_map(kind, n0 + n) * Kd + k0 + 8 * c) = o; }
    LDS_WAIT();
}
__device__ __forceinline__ void p0_transpose_item_f8(const float* W, int N, unsigned char* WT, int Kd, int kind, int nblk, int item, LAS float* scr, int lane, const float wscale = 64.0f) {
    const int kb = item / nblk, nb = item % nblk, k0 = 64 * kb, n0 = 32 * nb;
#pragma unroll 8
    for (int i = 0; i < 32; ++i) { const int kk = 2 * i + (lane >> 5); scr[kk * 33 + (lane & 31)] = __builtin_nontemporal_load(W + (size_t)(k0 + kk) * N + n0 + (lane & 31)) * wscale; }
    LDS_WAIT();
    const int c = lane & 7;
#pragma unroll
    for (int j = 0; j < 4; ++j) { const int n = (lane >> 3) + 8 * j; const LAS float* s = scr + (8 * c) * 33 + n;
        *(u32x2*)(WT + (size_t)drow_map(kind, n0 + n) * Kd + k0 + 8 * c) = (u32x2){pk4_fp8(s[0 * 33], s[1 * 33], s[2 * 33], s[3 * 33]), pk4_fp8(s[4 * 33], s[5 * 33], s[6 * 33], s[7 * 33])}; }
    LDS_WAIT();
}
__device__ __forceinline__ void phase_p0a() {
    const Frame F = make_frame();
    const KArgs ka = kargs_fresh(); unsigned char* const ws = ka->ws;
    bf16* Win_t = (bf16*)(ws + WS_WIN); bf16* Wout_t = (bf16*)(ws + WS_WOUT); unsigned char* Wgu_t = ws + WS_WGU; unsigned char* Wd_t = ws + WS_WD;
    {
        LAS float* scr = (LAS float*)(F.lds + F.wave * 16384);
        const int gw = F.bid * NWAVES + F.wave, NGW = F.G * NWAVES;
        constexpr int N_EXP = 64 * 768, N_IN = 2 * 768, N_OUT = 2 * 256;
        for (int it = gw; it < N_EXP + N_IN + N_OUT; it += NGW) {
            if (it < N_EXP) {
                const int le = it / 768, r = it % 768;
                if (r < 256) p0_transpose_item_f8(ka->in[I_WG] + (size_t)le * D * FE, FE, Wgu_t + (size_t)le * D * D, D, 2, 16, r, scr, F.lane);
                else if (r < 512) p0_transpose_item_f8(ka->in[I_WU] + (size_t)le * D * FE, FE, Wgu_t + (size_t)le * D * D, D, 3, 16, r - 256, scr, F.lane);
                else p0_transpose_item_f8(ka->in[I_WDN] + (size_t)le * FE * D, D, Wd_t + (size_t)le * D * FE, FE, 0, 32, r - 512, scr, F.lane);
            } else if (it < N_EXP + N_IN) {
                const int r0 = it - N_EXP, l = r0 / 768, r = r0 % 768;
                p0_transpose_item_f8(ka->in[I_WIN] + (size_t)l * D * INW, INW, (unsigned char*)Win_t + (size_t)l * INW * D, D, 1, 48, r, scr, F.lane, 32.0f);
            } else {
                const int r0 = it - N_EXP - N_IN, l = r0 / 256, r = r0 % 256;
                p0_transpose_item_f8(ka->in[I_WOUT] + (size_t)l * D * D, D, (unsigned char*)Wout_t + (size_t)l * D * D, D, 0, 32, r, scr, F.lane, 64.0f);
            }
        }
    }
    __syncthreads();
    {
        LAS float* pws = (LAS float*)F.lds;
        LAS float* wo = (LAS float*)(F.lds + 128 * 129 * 4);
        for (int item = F.bid; item < 256; item += F.G) {
            const int l = item >> 7, g = (item >> 5) & 3, n0 = (item & 31) * 32;
            const float* pw = ka->in[I_POOLW] + (size_t)(l * 4 + g) * 128 * 128; const float* ps = ka->in[I_POOLS] + l * 512 + g * 128;
            const float* wout = ka->in[I_WOUT] + (size_t)l * D * D + (size_t)(512 + g * 128) * D;
            for (int i = 0; i < 32; ++i) { const int idx = F.tid + 512 * i, c = idx >> 7, d = idx & 127; pws[c * 129 + d] = pw[idx] * ps[d]; }
            for (int i = 0; i < 8; ++i) { const int idx = F.tid + 512 * i, d = idx >> 5, nn = idx & 31; wo[idx] = wout[(size_t)d * D + n0 + nn]; }
            __syncthreads();
            const int c = F.tid & 127, nq = F.tid >> 7;
            float acc[8];
#pragma unroll
            for (int i = 0; i < 8; ++i) acc[i] = 0.f;
#pragma unroll 1
            for (int d0 = 0; d0 < 128; d0 += 8) {
                float a[8]; f32x4 wl[8], wh[8];
#pragma unroll
                for (int dd = 0; dd < 8; ++dd) { a[dd] = pws[c * 129 + d0 + dd]; wl[dd] = *(const LAS f32x4*)(wo + (d0 + dd) * 32 + nq * 8); wh[dd] = *(const LAS f32x4*)(wo + (d0 + dd) * 32 + nq * 8 + 4); }
#pragma unroll
                for (int dd = 0; dd < 8; ++dd)
#pragma unroll
                    for (int i = 0; i < 4; ++i) { acc[i] += a[dd] * wl[dd][i]; acc[4 + i] += a[dd] * wh[dd][i]; }
            }
#pragma unroll
            for (int i = 0; i < 8; ++i) ((unsigned char*)Wout_t)[(size_t)l * D * D + (size_t)(n0 + nq * 8 + i) * D + 512 + g * 128 + c] = (unsigned char)(pk4_fp8(acc[i] * 64.0f, 0.f, 0.f, 0.f) & 0xffu);
            __syncthreads();
        }
    }
    {
        LAS float* cact = (LAS float*)F.lds;
        float* modp = (float*)(ws + WS_MODP);
        for (int item = F.bid; item < 384; item += F.G) {
            const int l = item / 192, r = item % 192, kc = r / 12, jc = r % 12, k0 = kc * 64, j = jc * 512 + F.tid;
            { const int b = F.tid >> 6, kk = F.tid & 63; const float cv = ka->in[I_C][b * D + k0 + kk]; cact[F.tid] = cv * sigmoidf_(cv); }
            __syncthreads();
            float acc[8];
#pragma unroll
            for (int b = 0; b < 8; ++b) acc[b] = 0.f;
            const float* wp = ka->in[I_WADA] + (size_t)l * D * 6 * D + (size_t)k0 * 6 * D + j;
#pragma unroll 8
            for (int kk = 0; kk < 64; ++kk) { const float w = __builtin_nontemporal_load(wp + (size_t)kk * 6 * D);
#pragma unroll
                for (int b = 0; b < 8; ++b) acc[b] += cact[b * 64 + kk] * w; }
#pragma unroll
            for (int b = 0; b < 8; ++b) modp[((size_t)(kc * L + l) * NB + b) * 6 * D + j] = acc[b];
            __syncthreads();
        }
    }
    {
        bf16* hi = (bf16*)(ws + WS_WR); bf16* lo = hi + NE * D;
        for (int idx = F.bid * NT + F.tid; idx < NE * D; idx += F.G * NT) { const int e = idx >> 10, k = idx & 1023; const float v = ka->in[I_WR][k * NE + e];
            const unsigned h = f2bf(v); hi[idx] = (bf16)h; lo[idx] = (bf16)f2bf(v - bflo(h)); }
    }
}

__device__ __forceinline__ float mod_sum(const float* modp, const float* bada, int l, int b, int j) {
    float s = bada[l * 6 * D + j];
#pragma unroll
    for (int kc = 0; kc < 16; ++kc) s += modp[((size_t)(kc * L + l) * NB + b) * 6 * D + j];
    return s;
}
__device__ __forceinline__ void phase_p0b() {
    const Frame F = make_frame();
    const KArgs ka = kargs_fresh(); unsigned char* const ws = ka->ws;
    float* mod = (float*)(ws + WS_MOD); const float* modp = (const float*)(ws + WS_MODP); const float* bada = ka->in[I_BADA];
    for (int idx = F.bid * NT + F.tid; idx < L * NB * 6 * D; idx += F.G * NT) { const int l = idx / (NB * 6 * D), rem = idx % (NB * 6 * D), b = rem / (6 * D), j = rem % (6 * D); mod[idx] = mod_sum(modp, bada, l, b, j); }
    LAS float* sh = (LAS float*)F.lds; LAS float* sc = sh + D;
    unsigned char* __restrict__ uq = ws + WS_A; bf16* __restrict__ xbo = (bf16*)(ws + WS_E);
    const float* __restrict__ xin = ka->in[I_X];
    for (int chunk = F.bid; chunk < M / 256; chunk += F.G) {
        const int b = chunk >> 5;
        __syncthreads();
        for (int i = F.tid; i < 2 * D; i += NT) { const float s = mod_sum(modp, bada, 0, b, i); if (i < D) sh[i] = s; else sc[i - D] = 1.0f + s; }
        __syncthreads();
#pragma unroll 2
        for (int rr = 0; rr < 32; ++rr) {
            const size_t row = (size_t)chunk * 256 + F.wave * 32 + rr;
            f32x4 xv[2][2];
#pragma unroll
            for (int h = 0; h < 2; ++h) { xv[h][0] = __builtin_nontemporal_load((const f32x4*)(xin + row * D + h * 512 + 8 * F.lane)); xv[h][1] = __builtin_nontemporal_load((const f32x4*)(xin + row * D + h * 512 + 8 * F.lane + 4)); }
#pragma unroll
            for (int h = 0; h < 2; ++h) { const int col = h * 512 + 8 * F.lane; float xs[8], uo[8];
#pragma unroll
                for (int q = 0; q < 2; ++q) { const f32x4 s1 = *(const LAS f32x4*)(sc + col + 4 * q), s0 = *(const LAS f32x4*)(sh + col + 4 * q);
#pragma unroll
                    for (int j = 0; j < 4; ++j) { xs[4 * q + j] = xv[h][q][j]; uo[4 * q + j] = xv[h][q][j] * s1[j] + s0[j]; } }
                *(u32x4*)(xbo + row * D + col) = pack8(xs);
                *(u32x2*)(uq + row * D + col) = (u32x2){pk4_fp8(uo[0], uo[1], uo[2], uo[3]), pk4_fp8(uo[4], uo[5], uo[6], uo[7])}; }
        }
    }
}

struct Prob1 {
    static constexpr bool GATHER = false;
    int tid;
    int K; StaticOrderC<M / 256, INW / 256> S; const char* A; const char* Bt; bf16* vp; const LAS float* b_in;
    __device__ __forceinline__ bool next(int i, Unit& u) const { return S.next(i, u); }
    __device__ __forceinline__ void resolve(const Unit& u, int, const char*& a, const char*& b, unsigned& o00, unsigned& o01, unsigned& o10, unsigned& o11) const {
        a = A + (size_t)u.pm * 256 * D; b = Bt + (size_t)u.pn * 256 * D; pg8::lin_offsets(tid, D, o00, o01, o10, o11); }
    __device__ __forceinline__ void epi(const Unit& u, int, const f32x4 (&acc)[2][2][4][2], int wr, int wc, int fr, int fq) const { const Epi1 E{vp, b_in, u.pm * 256, u.pn}; pg8::run_epi(E, acc, wr, wc, fr, fq); }
};
__device__ __forceinline__ void phase_gemm1(int l) {
    const Frame F = make_frame();
    const KArgs ka = kargs_fresh(); unsigned char* const ws = ka->ws;
    Prob1 P; P.tid = F.tid; P.K = D; P.S.init(M / 256, INW / 256, F.G, F.bid); P.A = (const char*)(ws + WS_A); P.Bt = (const char*)(ws + WS_WIN) + (size_t)l * INW * D; P.vp = (bf16*)(ws + WS_B);
    { LAS float* bl = (LAS float*)(F.lds + LDS_EPIC); const float* bg = ka->in[I_BIN] + l * INW; for (int i = F.tid; i < INW; i += NT) bl[i] = bg[i]; P.b_in = bl; __syncthreads(); }
    pg8::gemm_phase<Prob1, true, true>(F.lds, P, F.tid);
}

__device__ __forceinline__ void phase_convpool(int l) {
    const Frame F = make_frame();
    const KArgs ka = kargs_fresh(); unsigned char* const ws = ka->ws;
    const bf16* __restrict__ vp = (const bf16*)(ws + WS_B); bf16* __restrict__ A2 = (bf16*)(ws + WS_A);
    const float* cw = ka->in[I_CONVW] + l * CK * CW; const float* cb = ka->in[I_CONVB] + l * CW; const float* lg = ka->in[I_CLNG] + l * CW; const float* lb = ka->in[I_CLNB] + l * CW;
    LAS bf16* vin = (LAS bf16*)F.lds;
    LAS float* yo = (LAS float*)(F.lds + 63488);
    const int cp = F.tid & 255, rh = F.tid >> 8, chunk = F.tid & 63, prow = F.tid >> 6;
    h16x2 w2[CK];
#pragma unroll
    for (int j = 0; j < CK; ++j) w2[j] = __builtin_convertvector(*(const f32x2*)(cw + j * CW + 2 * cp), h16x2);
    const f32x2 cb2 = *(const f32x2*)(cb + 2 * cp);
    const f32x4 ga = *(const f32x4*)(lg + 8 * F.lane), gb = *(const f32x4*)(lg + 8 * F.lane + 4), ba = *(const f32x4*)(lb + 8 * F.lane), bb = *(const f32x4*)(lb + 8 * F.lane + 4);
    u32x4 vreg[8], preg[6];
#define CP_LOADV(tile_) do { const int row0_ = (tile_) * 32, t0_ = row0_ & (SEQ - 1); _Pragma("unroll") for (int pass = 0; pass < 8; ++pass) { const int r = pass * 8 + prow; vreg[pass] = (u32x4){0u, 0u, 0u, 0u}; \
        if (r < 62 && t0_ - 30 + r >= 0) vreg[pass] = *(const u32x4*)(vp + (size_t)(row0_ - 30 + r) * D + chunk * 8); } } while (0)
#define CP_LOADP(tile_) do { const int row0_ = (tile_) * 32, t0_ = row0_ & (SEQ - 1); _Pragma("unroll") for (int pass = 0; pass < 6; ++pass) { const int r = pass * 8 + prow; preg[pass] = (u32x4){0u, 0u, 0u, 0u}; \
        if (r < 47 && t0_ - 15 + r >= 0) preg[pass] = *(const u32x4*)(vp + (size_t)(row0_ - 15 + r) * D + 512 + chunk * 8); } } while (0)
    const bool owned = (F.G == M / 256);
    const int tstep = owned ? 1 : F.G, tend = owned ? 8 * F.bid + 8 : M / 32;
    int tile = owned ? 8 * F.bid : F.bid;
    if (tile < tend) CP_LOADV(tile);
#pragma unroll 1
    for (; tile < tend; tile += tstep) {
        const int row0 = tile * 32, t0 = row0 & (SEQ - 1);
#pragma unroll
        for (int pass = 0; pass < 8; ++pass) { const int r = pass * 8 + prow; if (r < 62) *(LAS u32x4*)(vin + r * 512 + chunk * 8) = vreg[pass]; }
        __syncthreads();
        if (tile + tstep < tend) CP_LOADV(tile + tstep);
        CP_LOADP(tile);
#pragma unroll 1
        for (int strip = 0; strip < 2; ++strip) {
            const int o0 = rh * 16 + strip * 8;
            h16x2 a2[8];
#pragma unroll
            for (int o = 0; o < 8; ++o) a2[o] = (h16x2){(_Float16)0.f, (_Float16)0.f};
            unsigned xr[38];
#pragma unroll
            for (int j = 0; j < 38; ++j) xr[j] = *(const LAS unsigned*)(vin + (o0 + j) * 512 + 2 * cp);
#pragma unroll
            for (int j = 0; j < 38; ++j) { const h16x2 x2 = __builtin_bit_cast(h16x2, xr[j]);
#pragma unroll
                for (int o = 0; o < 8; ++o) { const int tap = j - o; if (tap >= 0 && tap < CK) a2[o] += w2[tap] * x2; } }
#pragma unroll
            for (int o = 0; o < 8; ++o) *(LAS f32x2*)(yo + (o0 + o) * 512 + 2 * cp) = (f32x2){(float)a2[o].x + cb2.x, (float)a2[o].y + cb2.y};
        }
        __syncthreads();
#pragma unroll
        for (int pass = 0; pass < 6; ++pass) { const int r = pass * 8 + prow; if (r < 47) *(LAS u32x4*)(vin + r * 512 + chunk * 8) = preg[pass]; }
#pragma unroll 1
        for (int rr = 0; rr < 4; ++rr) { const int r = F.wave * 4 + rr;
            const f32x4 a = *(const LAS f32x4*)(yo + r * 512 + 8 * F.lane), b = *(const LAS f32x4*)(yo + r * 512 + 8 * F.lane + 4);
            const float mean = wave_sum((a[0] + a[1]) + (a[2] + a[3]) + (b[0] + b[1]) + (b[2] + b[3])) * (1.0f / 512.0f);
            const f32x4 da = a - mean, db = b - mean;
            const float var = wave_sum((da[0] * da[0] + da[1] * da[1]) + (da[2] * da[2] + da[3] * da[3]) + (db[0] * db[0] + db[1] * db[1]) + (db[2] * db[2] + db[3] * db[3])) * (1.0f / 512.0f);
            const float rstd = __builtin_amdgcn_rsqf(var + LN_EPS);
            float o[8];
#pragma unroll
            for (int j = 0; j < 4; ++j) { const float ya = da[j] * rstd * ga[j] + ba[j], yb = db[j] * rstd * gb[j] + bb[j]; o[j] = ya * sigmoidf_(ya); o[4 + j] = yb * sigmoidf_(yb); }
            *(u32x2*)((unsigned char*)A2 + (size_t)(row0 + r) * D + 8 * F.lane) = (u32x2){pk4_fp8(o[0], o[1], o[2], o[3]), pk4_fp8(o[4], o[5], o[6], o[7])};
        }
        __syncthreads();
        {
            const int w = 2 << (chunk >> 4), o0 = F.wave * 4;
            float sacc[8];
#pragma unroll
            for (int j = 0; j < 8; ++j) sacc[j] = 0.f;
#pragma unroll
            for (int i = 1; i < 16; ++i) { if (i < w) { float e[8]; unpack8(*(const LAS u32x4*)(vin + (o0 + 15 - i) * 512 + chunk * 8), e);
#pragma unroll
                    for (int j = 0; j < 8; ++j) sacc[j] += e[j]; } }
#pragma unroll
            for (int o = 0; o < 4; ++o) { const int li = o0 + o + 15; float cur[8]; unpack8(*(const LAS u32x4*)(vin + li * 512 + chunk * 8), cur);
                const int t = t0 + o0 + o; const float inv = __builtin_amdgcn_rcpf((float)((t + 1) < w ? (t + 1) : w)); float dd[8];
#pragma unroll
                for (int j = 0; j < 8; ++j) { sacc[j] += cur[j]; dd[j] = sacc[j] * inv - cur[j]; }
                *(u32x2*)((unsigned char*)A2 + (size_t)(row0 + o0 + o) * D + 512 + chunk * 8) = (u32x2){pk4_fp8(dd[0], dd[1], dd[2], dd[3]), pk4_fp8(dd[4], dd[5], dd[6], dd[7])};
                float old[8]; unpack8(*(const LAS u32x4*)(vin + (li - (w - 1)) * 512 + chunk * 8), old);
#pragma unroll
                for (int j = 0; j < 8; ++j) sacc[j] -= old[j]; }
        }
        __syncthreads();
    }
#undef CP_LOADV
#undef CP_LOADP
}

struct Prob2 {
    static constexpr bool GATHER = false;
    int tid;
    int K; StaticOrderC<M / 256, D / 256> S; const char* A; const char* Bt; bf16* y; const bf16* xb; const LAS float* bo; const LAS float* gg; float* part;
    __device__ __forceinline__ bool next(int i, Unit& u) const { return S.next(i, u); }
    __device__ __forceinline__ void resolve(const Unit& u, int, const char*& a, const char*& b, unsigned& o00, unsigned& o01, unsigned& o10, unsigned& o11) const {
        a = A + (size_t)u.pm * 256 * D; b = Bt + (size_t)u.pn * 256 * D; pg8::lin_offsets(tid, D, o00, o01, o10, o11); }
    __device__ __forceinline__ void epi(const Unit& u, int, const f32x4 (&acc)[2][2][4][2], int wr, int wc, int fr, int fq) const {
        const Epi2 E{y, xb, bo, gg, part, u.pm * 256, u.pn}; pg8::run_epi(E, acc, wr, wc, fr, fq); }
};
__device__ __forceinline__ void phase_gemm2(int l) {
    const Frame F = make_frame();
    const KArgs ka = kargs_fresh(); unsigned char* const ws = ka->ws;
    Prob2 P; P.tid = F.tid; P.K = D; P.S.init(M / 256, D / 256, F.G, F.bid); P.A = (const char*)(ws + WS_A); P.Bt = (const char*)(ws + WS_WOUT) + (size_t)l * D * D; P.y = (bf16*)(ws + WS_C);
    P.xb = (const bf16*)(ws + WS_E); P.part = (float*)(ws + WS_PART);
    {
        LAS float* bl = (LAS float*)(F.lds + LDS_EPIC); LAS float* gl = bl + D; const float* bg = ka->in[I_BOUT] + l * D; const float* gm = (const float*)(ws + WS_MOD) + (size_t)(l * NB + (F.bid >> 5)) * 6 * D + 2 * D;
        for (int i = F.tid; i < D; i += NT) { bl[i] = bg[i]; gl[i] = 1.0f + gm[i]; } P.bo = bl; P.gg = gl; __syncthreads(); }
    pg8::gemm_phase<Prob2, true, true>(F.lds, P, F.tid);
}

__device__ __forceinline__ void phase_ln1route(int l) {
    const Frame F = make_frame();
    const KArgs ka = kargs_fresh(); unsigned char* const ws = ka->ws;
    const bf16* __restrict__ y = (const bf16*)(ws + WS_C); unsigned char* __restrict__ u2q = ws + WS_A;
    const float* mod = (const float*)(ws + WS_MOD); float* stats = (float*)(ws + WS_STATS); const float* part = (const float*)(ws + WS_PART);
    const bf16* wr_hi = (const bf16*)(ws + WS_WR); const bf16* wr_lo = wr_hi + NE * D;
    unsigned* gcount = (unsigned*)(ws + WS_CTL) + CW_CNT + l * NE;
    int* listd = (int*)(ws + WS_LISTD); float* listw = (float*)(ws + WS_LISTW);
    LAS float* Pc = (LAS float*)F.lds; LAS float* Qc = Pc + D;
    LAS float* lgw = (LAS float*)(F.lds + 8192) + F.wave * 32 * 33;
    LAS int* lcnt = (LAS int*)(F.lds + 8192 + 8 * 32 * 33 * 4);
    LAS int* gbase = lcnt + 32;
    LAS int* asg_e = gbase + 32; LAS int* asg_r = asg_e + 512; LAS int* asg_d = asg_r + 512; LAS float* asg_w = (LAS float*)(asg_d + 512);
    const int fr = F.lane & 15, fq = F.lane >> 4;
    const float* rb = ka->in[I_RB];
    for (int chunk = F.bid; chunk < M / 256; chunk += F.G) {
        const int b = chunk >> 5;
        __syncthreads();
        for (int i = F.tid; i < D; i += NT) { const float g = ka->in[I_LN1G][l * D + i], bb = ka->in[I_LN1B][l * D + i];
            const float sc2 = 1.0f + mod[(size_t)(l * NB + b) * 6 * D + 4 * D + i], sh2 = mod[(size_t)(l * NB + b) * 6 * D + 3 * D + i];
            Pc[i] = g * sc2; Qc[i] = bb * sc2 + sh2; }
        if (F.tid < 32) lcnt[F.tid] = 0;
        __syncthreads();
        const int R0 = chunk * 256 + F.wave * 32;
        float mu[2], rs[2];
#pragma unroll
        for (int m = 0; m < 2; ++m) {
            const float* pp = part + ((size_t)(4 * fq) * M + R0 + 16 * m + fr) * 2;
            const f32x2 p0 = *(const f32x2*)pp, p1 = *(const f32x2*)(pp + (size_t)2 * M), p2 = *(const f32x2*)(pp + (size_t)4 * M), p3 = *(const f32x2*)(pp + (size_t)6 * M);
            float s = (p0.x + p1.x) + (p2.x + p3.x), q = (p0.y + p1.y) + (p2.y + p3.y);
            s += __shfl_xor(s, 16); s += __shfl_xor(s, 32); q += __shfl_xor(q, 16); q += __shfl_xor(q, 32);
            const float mean = s * (1.0f / D); float var = q * (1.0f / D) - mean * mean; var = var < 0.f ? 0.f : var;
            mu[m] = mean; rs[m] = __builtin_amdgcn_rsqf(var + LN_EPS);
            if (fq == 0) *(f32x2*)(stats + (size_t)(R0 + 16 * m + fr) * 2) = (f32x2){mean, rs[m]};
        }
        f32x4 acc[2][2];
#pragma unroll
        for (int m = 0; m < 2; ++m)
#pragma unroll
            for (int n = 0; n < 2; ++n) acc[m][n] = (f32x4){0.f, 0.f, 0.f, 0.f};
        const bf16* yr0 = y + (size_t)(R0 + fr) * D + 16 * fq; const bf16* yr1 = yr0 + (size_t)16 * D;
        unsigned char* ur0 = u2q + (size_t)(R0 + fr) * D + 16 * fq; unsigned char* ur1 = ur0 + (size_t)16 * D;
        const bf16* wh0 = wr_hi + (size_t)fr * D + 16 * fq; const bf16* wl0 = wr_lo + (size_t)fr * D + 16 * fq;
        u32x4 yc[2][2]; bf16x8 bhc[2][2], blc[2][2];
#pragma unroll
        for (int c = 0; c < 2; ++c) { yc[0][c] = *(const u32x4*)(yr0 + 8 * c); yc[1][c] = *(const u32x4*)(yr1 + 8 * c);
#pragma unroll
            for (int n = 0; n < 2; ++n) { bhc[n][c] = *(const bf16x8*)(wh0 + (size_t)n * 16 * D + 8 * c); blc[n][c] = *(const bf16x8*)(wl0 + (size_t)n * 16 * D + 8 * c); } }
#pragma unroll 1
        for (int it = 0; it < 16; ++it) {
            const int k = 64 * it + 16 * fq, kn = (it < 15) ? 64 * (it + 1) : 0;
            u32x4 yn[2][2]; bf16x8 bhn[2][2], bln[2][2];
#pragma unroll
            for (int c = 0; c < 2; ++c) { yn[0][c] = *(const u32x4*)(yr0 + kn + 8 * c); yn[1][c] = *(const u32x4*)(yr1 + kn + 8 * c);
#pragma unroll
                for (int n = 0; n < 2; ++n) { bhn[n][c] = *(const bf16x8*)(wh0 + (size_t)n * 16 * D + kn + 8 * c); bln[n][c] = *(const bf16x8*)(wl0 + (size_t)n * 16 * D + kn + 8 * c); } }
            float pc[16], qc[16];
#pragma unroll
            for (int c4 = 0; c4 < 4; ++c4) { const f32x4 pv = *(const LAS f32x4*)(Pc + k + 4 * c4), qv = *(const LAS f32x4*)(Qc + k + 4 * c4);
#pragma unroll
                for (int j = 0; j < 4; ++j) { pc[4 * c4 + j] = pv[j]; qc[4 * c4 + j] = qv[j]; } }
            bf16x8 ah[2][2], al[2][2];
#pragma unroll
            for (int m = 0; m < 2; ++m) {
                float uv[16];
#pragma unroll
                for (int c = 0; c < 2; ++c) { float e[8]; unpack8(yc[m][c], e);
#pragma unroll
                    for (int j = 0; j < 8; ++j) uv[8 * c + j] = (e[j] - mu[m]) * rs[m] * pc[8 * c + j] + qc[8 * c + j]; }
                *(u32x4*)((m ? ur1 : ur0) + 64 * it) = (u32x4){pk4_fp8(uv[0], uv[1], uv[2], uv[3]), pk4_fp8(uv[4], uv[5], uv[6], uv[7]), pk4_fp8(uv[8], uv[9], uv[10], uv[11]), pk4_fp8(uv[12], uv[13], uv[14], uv[15])};
#pragma unroll
                for (int c = 0; c < 2; ++c) { float h8[8], d8[8];
#pragma unroll
                    for (int j = 0; j < 8; ++j) h8[j] = uv[8 * c + j];
                    const u32x4 hv = pack8(h8); float hb[8]; unpack8(hv, hb);
#pragma unroll
                    for (int j = 0; j < 8; ++j) d8[j] = h8[j] - hb[j];
                    ah[m][c] = __builtin_bit_cast(bf16x8, hv); al[m][c] = __builtin_bit_cast(bf16x8, pack8(d8)); }
            }
#pragma unroll
            for (int c = 0; c < 2; ++c)
#pragma unroll
                for (int n = 0; n < 2; ++n)
#pragma unroll
                    for (int m = 0; m < 2; ++m) {
                        acc[m][n] = __builtin_amdgcn_mfma_f32_16x16x32_bf16(bhc[n][c], ah[m][c], acc[m][n], 0, 0, 0);
                        acc[m][n] = __builtin_amdgcn_mfma_f32_16x16x32_bf16(bhc[n][c], al[m][c], acc[m][n], 0, 0, 0);
                        acc[m][n] = __builtin_amdgcn_mfma_f32_16x16x32_bf16(blc[n][c], ah[m][c], acc[m][n], 0, 0, 0);
                    }
#pragma unroll
            for (int c = 0; c < 2; ++c) { yc[0][c] = yn[0][c]; yc[1][c] = yn[1][c];
#pragma unroll
                for (int n = 0; n < 2; ++n) { bhc[n][c] = bhn[n][c]; blc[n][c] = bln[n][c]; } }
        }
#pragma unroll
        for (int m = 0; m < 2; ++m)
#pragma unroll
            for (int n = 0; n < 2; ++n)
#pragma unroll
                for (int j = 0; j < 4; ++j) lgw[(16 * m + fr) * 33 + 16 * n + 4 * fq + j] = acc[m][n][j];
        LDS_WAIT();
        if (F.lane < 32) {
            float bestg = -1e30f; int be0 = 0, be1 = 0; float bs0 = 0.f, bs1 = 0.f;
#pragma unroll 1
            for (int g = 0; g < 4; ++g) {
                float m1 = -1e30f, m2 = -1e30f, s1 = 0.f, s2 = 0.f; int i1 = 0, i2 = 0;
#pragma unroll
                for (int i = 0; i < 8; ++i) { const int e = g * 8 + i; const float sc = sigmoidf_(lgw[F.lane * 33 + e]); const float sel = sc + rb[e];
                    if (sel > m1) { m2 = m1; i2 = i1; s2 = s1; m1 = sel; i1 = e; s1 = sc; } else if (sel > m2) { m2 = sel; i2 = e; s2 = sc; } }
                const float gs = m1 + m2;
                if (gs > bestg) { bestg = gs; be0 = i1; be1 = i2; bs0 = s1; bs1 = s2; }
            }
            const float inv = __builtin_amdgcn_rcpf(bs0 + bs1);
            const int tok = R0 + F.lane, slot = F.wave * 64 + F.lane * 2;
            const int r0 = atomicAdd((int*)&lcnt[be0], 1); const int r1 = atomicAdd((int*)&lcnt[be1], 1);
            asg_e[slot] = be0; asg_r[slot] = r0; asg_d[slot] = tok * 2; asg_w[slot] = bs0 * inv;
            asg_e[slot + 1] = be1; asg_r[slot + 1] = r1; asg_d[slot + 1] = tok * 2 + 1; asg_w[slot + 1] = bs1 * inv;
        }
        __syncthreads();
        if (F.tid < 32) gbase[F.tid] = (int)atomicAdd(&gcount[F.tid], (unsigned)lcnt[F.tid]);
        __syncthreads();
        { const int e = asg_e[F.tid], pos = gbase[e] + asg_r[F.tid]; listd[e * LISTCAP + pos] = asg_d[F.tid]; listw[e * LISTCAP + pos] = asg_w[F.tid]; }
    }
}

constexpr int LDS_ULIST = 131 * 1024;
constexpr int LDS_TILEE = 128 * 1024, LDS_TOFF = 132 * 1024, LDS_TABW = 134 * 1024, LDS_TAB = 145 * 1024, MOE_MAXU = 10;
__device__ __forceinline__ void moe_table(const Frame& F, const unsigned char* ws, int l, LAS int* toff, LAS int* ncnt, LAS int* tile_e) {
    const unsigned* gcount = (const unsigned*)(ws + WS_CTL) + CW_CNT + l * NE;
    __syncthreads();
    if (F.tid < NE) ncnt[F.tid] = (int)__hip_atomic_load(gcount + F.tid, __ATOMIC_RELAXED, __HIP_MEMORY_SCOPE_AGENT);
    __syncthreads();
    if (F.tid == 0) { int acc = 0; for (int e = 0; e < NE; ++e) { toff[e] = acc; acc += (ncnt[e] + 255) >> 8; } toff[NE] = acc; }
    __syncthreads();
    for (int pm = F.tid; pm < toff[NE]; pm += NT) { int e = 0; while (e < NE - 1 && toff[e + 1] <= pm) ++e; tile_e[pm] = e; }
    __syncthreads();
}

struct Prob3 {
    static constexpr bool GATHER = true;
    int tid;
    int K; StaticOrder S; const LAS int* toff; const LAS int* ncnt; const LAS int* tile_e; const LAS int* tab; const LAS int* ulist; const char* u2; const char* W; const int* listd; unsigned char* hm;
    __device__ __forceinline__ bool next(int i, Unit& u) const { if (i >= MOE_MAXU) return false; const int v = ulist[i]; u.pm = v >> 2; u.pn = v & 3; return v >= 0; }
    __device__ __forceinline__ void resolve(const Unit& u, int i, const char*& a, const char*& b, unsigned& o00, unsigned& o01, unsigned& o10, unsigned& o11) const {
        const int e = tile_e[u.pm];
        a = u2; b = W + (size_t)e * D * D + (size_t)u.pn * 256 * D;
        int R0, C0, R1, C1; pg8::stage_rc(tid * 16, R0, C0); pg8::stage_rc(tid * 16 + 8192, R1, C1);
        const LAS int* t = tab + i * 256; const int t00 = t[R0], t01 = t[R1], t10 = t[R0 + 128], t11 = t[R1 + 128];
        o00 = (unsigned)(t00 * D + C0 * 2); o01 = (unsigned)(t01 * D + C1 * 2); o10 = (unsigned)(t10 * D + C0 * 2); o11 = (unsigned)(t11 * D + C1 * 2);
    }
    __device__ __forceinline__ void epi(const Unit& u, int i, const f32x4 (&acc)[2][2][4][2], int wr, int wc, int fr, int fq) const { const Epi3 E{hm, u.pm * 256, u.pn}; pg8::run_epi(E, acc, wr, wc, fr, fq); }
};
struct Prob4 {
    static constexpr bool GATHER = false;
    int tid;
    int K; StaticOrder S; const LAS int* toff; const LAS int* ncnt; const LAS int* tile_e; const LAS int* tabd; const LAS float* tabw; const LAS int* ulist; const char* hm; const char* W; const int* listd; const float* listw; unsigned char* ct;
    __device__ __forceinline__ bool next(int i, Unit& u) const { if (i >= MOE_MAXU) return false; const int v = ulist[i]; u.pm = v >> 2; u.pn = v & 3; return v >= 0; }
    __device__ __forceinline__ void resolve(const Unit& u, int i, const char*& a, const char*& b, unsigned& o00, unsigned& o01, unsigned& o10, unsigned& o11) const {
        const int e = tile_e[u.pm];
        a = hm + (size_t)u.pm * 256 * FE; b = W + (size_t)e * D * FE + (size_t)u.pn * 256 * FE; pg8::lin_offsets(tid, FE, o00, o01, o10, o11); }
    __device__ __forceinline__ void epi(const Unit& u, int i, const f32x4 (&acc)[2][2][4][2], int wr, int wc, int fr, int fq) const {
        const Epi4<3> E{ct, tabd + i * 256, tabw + i * 256, u.pn}; pg8::run_epi(E, acc, wr, wc, fr, fq);
    }
};
__device__ __forceinline__ void phase_gemm3(int l) {
    const Frame F = make_frame();
    const KArgs ka = kargs_fresh(); unsigned char* const ws = ka->ws;
    LAS int* toff = (LAS int*)(F.lds + LDS_TOFF); LAS int* ncnt = toff + 40; LAS int* tile_e = (LAS int*)(F.lds + LDS_TILEE); LAS int* tab = (LAS int*)(F.lds + LDS_TAB);
    moe_table(F, ws, l, toff, ncnt, tile_e);
    Prob3 P; P.tid = F.tid; P.K = D; P.S.init(toff[NE], 4, F.G, F.bid); P.toff = toff; P.ncnt = ncnt; P.tile_e = tile_e; P.tab = tab; P.u2 = (const char*)(ws + WS_A); P.W = (const char*)(ws + WS_WGU) + (size_t)l * NE * D * D;
    P.listd = (const int*)(ws + WS_LISTD); P.hm = (unsigned char*)(ws + WS_B);
    { LAS int* ul = (LAS int*)(F.lds + LDS_ULIST); P.ulist = ul; if (F.tid < MOE_MAXU) { Unit u; ul[F.tid] = P.S.next(F.tid, u) ? (u.pm * 4 + u.pn) : -1; } __syncthreads(); }
    {
        const int r = F.tid & 255, i0 = F.tid >> 8; int v[MOE_MAXU / 2];
#pragma unroll
        for (int k = 0; k < MOE_MAXU / 2; ++k) { Unit u; v[k] = 0; if (P.next(i0 + 2 * k, u)) { const int e = tile_e[u.pm], ti = u.pm - toff[e]; if (r < ncnt[e] - ti * 256) v[k] = P.listd[e * LISTCAP + ti * 256 + r] >> 1; } }
#pragma unroll
        for (int k = 0; k < MOE_MAXU / 2; ++k) tab[(i0 + 2 * k) * 256 + r] = v[k];
        __syncthreads();
    }
    pg8::gemm_phase<Prob3, true, true>(F.lds, P, F.tid);
}
__device__ __forceinline__ void phase_gemm4(int l) {
    const Frame F = make_frame();
    const KArgs ka = kargs_fresh(); unsigned char* const ws = ka->ws;
    LAS int* toff = (LAS int*)(F.lds + LDS_TOFF); LAS int* ncnt = toff + 40; LAS int* tile_e = (LAS int*)(F.lds + LDS_TILEE); LAS int* tabd = (LAS int*)(F.lds + LDS_TAB); LAS float* tabw = (LAS float*)(F.lds + LDS_TABW);
    moe_table(F, ws, l, toff, ncnt, tile_e);
    Prob4 P; P.tid = F.tid; P.K = FE; P.S.init(toff[NE], 4, F.G, F.bid); P.toff = toff; P.ncnt = ncnt; P.tile_e = tile_e; P.tabd = tabd; P.tabw = tabw; P.hm = (const char*)(ws + WS_B); P.W = (const char*)(ws + WS_WD) + (size_t)l * NE * D * FE;
    P.listd = (const int*)(ws + WS_LISTD); P.listw = (const float*)(ws + WS_LISTW); P.ct = ws + WS_D;
    { LAS int* ul = (LAS int*)(F.lds + LDS_ULIST); P.ulist = ul; if (F.tid < MOE_MAXU) { Unit u; ul[F.tid] = P.S.next(F.tid, u) ? (u.pm * 4 + u.pn) : -1; } __syncthreads(); }
    {
        const int r = F.tid & 255, i0 = F.tid >> 8; int vd[MOE_MAXU / 2]; float vw[MOE_MAXU / 2];
#pragma unroll
        for (int k = 0; k < MOE_MAXU / 2; ++k) { Unit u; vd[k] = -1; vw[k] = 0.f; if (P.next(i0 + 2 * k, u)) { const int e = tile_e[u.pm], ti = u.pm - toff[e]; if (r < ncnt[e] - ti * 256) { vd[k] = P.listd[e * LISTCAP + ti * 256 + r]; vw[k] = P.listw[e * LISTCAP + ti * 256 + r] * 0.25f; } } }
#pragma unroll
        for (int k = 0; k < MOE_MAXU / 2; ++k) { tabd[(i0 + 2 * k) * 256 + r] = vd[k]; tabw[(i0 + 2 * k) * 256 + r] = vw[k]; }
        __syncthreads();
    }
    pg8::gemm_phase<Prob4, true, true>(F.lds, P, F.tid);
}

__device__ __forceinline__ void unpack_fp8x16(const u32x4 v, float (&e)[16]) {
#pragma unroll
    for (int q = 0; q < 4; ++q) { const unsigned w = v[q]; const f32x2 lo = __builtin_amdgcn_cvt_pk_f32_fp8(w, false), hi = __builtin_amdgcn_cvt_pk_f32_fp8(w, true); e[4 * q] = lo[0]; e[4 * q + 1] = lo[1]; e[4 * q + 2] = hi[0]; e[4 * q + 3] = hi[1]; }
}
__device__ __forceinline__ void phase_ln2(int l) {
    const Frame F = make_frame();
    const KArgs ka = kargs_fresh(); unsigned char* const ws = ka->ws;
    const bf16* __restrict__ y = (const bf16*)(ws + WS_C); const unsigned char* __restrict__ ct = ws + WS_D;
    const float* mod = (const float*)(ws + WS_MOD); const float* stats = (const float*)(ws + WS_STATS);
    bf16* __restrict__ x2 = (bf16*)(ws + WS_E); bf16* __restrict__ un = (bf16*)(ws + WS_A); float* __restrict__ outp = ka->out;
    const int gw = F.bid * NWAVES + F.wave, NGW = F.G * NWAVES, rpw = (M + NGW - 1) / NGW;
    const int r0 = gw * rpw, r1 = (r0 + rpw) < M ? (r0 + rpw) : M;
    const int c0 = 16 * F.lane;
    float ag[16], ab[16], g2v[16], b2v[16], mg[16], sc[16], sh[16];
#pragma unroll
    for (int q = 0; q < 4; ++q) { const f32x4 a = *(const f32x4*)(ka->in[I_LN1G] + l * D + c0 + 4 * q), b = *(const f32x4*)(ka->in[I_LN1B] + l * D + c0 + 4 * q), c = *(const f32x4*)(ka->in[I_LN2G] + l * D + c0 + 4 * q), d = *(const f32x4*)(ka->in[I_LN2B] + l * D + c0 + 4 * q);
#pragma unroll
        for (int j = 0; j < 4; ++j) { ag[4 * q + j] = ALPHA * a[j]; ab[4 * q + j] = ALPHA * b[j]; g2v[4 * q + j] = c[j]; b2v[4 * q + j] = d[j]; } }
    int bcur = -1;
    constexpr int RIF = 4;
#pragma unroll 1
    for (int row = r0; row < r1; row += RIF) {
        const int b = row >> 13;
        if (b != bcur) { bcur = b; const float* mb = mod + (size_t)(l * NB + b) * 6 * D; const float* mn = mod + (size_t)((l + 1 < L ? l + 1 : l) * NB + b) * 6 * D;
#pragma unroll
            for (int q = 0; q < 4; ++q) { const f32x4 a = *(const f32x4*)(mb + 5 * D + c0 + 4 * q), c = *(const f32x4*)(mn + D + c0 + 4 * q), d = *(const f32x4*)(mn + c0 + 4 * q);
#pragma unroll
                for (int j = 0; j < 4; ++j) { mg[4 * q + j] = (1.0f + a[j]) * 0.0625f; sc[4 * q + j] = 1.0f + c[j]; sh[4 * q + j] = d[j]; } } }
        u32x4 vy[RIF][2], v0[RIF], v1[RIF]; f32x2 st[RIF];
#pragma unroll
        for (int rr = 0; rr < RIF; ++rr) { const size_t r = (row + rr) < r1 ? (row + rr) : (r1 - 1); st[rr] = *(const f32x2*)(stats + r * 2);
            vy[rr][0] = __builtin_nontemporal_load((const u32x4*)(y + r * D + c0)); vy[rr][1] = __builtin_nontemporal_load((const u32x4*)(y + r * D + c0 + 8)); v0[rr] = __builtin_nontemporal_load((const u32x4*)(ct + (2 * r) * D + c0)); v1[rr] = __builtin_nontemporal_load((const u32x4*)(ct + (2 * r + 1) * D + c0)); }
#pragma unroll
        for (int rr = 0; rr < RIF; ++rr) {
            const size_t r = (row + rr) < r1 ? (row + rr) : (r1 - 1); const bool live = (row + rr) < r1;
            float z[16], e0[16], e1[16], ey[16]; float s = 0.f;
            { float t8[8]; unpack8(vy[rr][0], t8);
#pragma unroll
              for (int j = 0; j < 8; ++j) ey[j] = t8[j];
              unpack8(vy[rr][1], t8);
#pragma unroll
              for (int j = 0; j < 8; ++j) ey[8 + j] = t8[j]; }
            unpack_fp8x16(v0[rr], e0); unpack_fp8x16(v1[rr], e1);
#pragma unroll
            for (int j = 0; j < 16; ++j) { const float v = (ey[j] - st[rr].x) * st[rr].y * ag[j] + ab[j] + mg[j] * (e0[j] + e1[j]); z[j] = v; s += v; }
            const float mean = wave_sum(s) * (1.0f / D); float q = 0.f;
#pragma unroll
            for (int j = 0; j < 16; ++j) { z[j] -= mean; q += z[j] * z[j]; }
            const float rstd = __builtin_amdgcn_rsqf(wave_sum(q) * (1.0f / D) + LN_EPS);
            if (live) {
                float o[16];
#pragma unroll
                for (int j = 0; j < 16; ++j) o[j] = z[j] * rstd * g2v[j] + b2v[j];
                if (l == L - 1) {
#pragma unroll
                    for (int q4 = 0; q4 < 4; ++q4) *(f32x4*)(outp + r * D + c0 + 4 * q4) = (f32x4){o[4 * q4], o[4 * q4 + 1], o[4 * q4 + 2], o[4 * q4 + 3]};
                } else {
                    float uo[16];
#pragma unroll
                    for (int j = 0; j < 16; ++j) uo[j] = o[j] * sc[j] + sh[j];
#pragma unroll
                    for (int h = 0; h < 2; ++h) {
                        *(u32x4*)(x2 + r * D + c0 + 8 * h) = (u32x4){pk2(o[8 * h], o[8 * h + 1]), pk2(o[8 * h + 2], o[8 * h + 3]), pk2(o[8 * h + 4], o[8 * h + 5]), pk2(o[8 * h + 6], o[8 * h + 7])};
                        *(u32x2*)((unsigned char*)un + r * D + c0 + 8 * h) = (u32x2){pk4_fp8(uo[8 * h], uo[8 * h + 1], uo[8 * h + 2], uo[8 * h + 3]), pk4_fp8(uo[8 * h + 4], uo[8 * h + 5], uo[8 * h + 6], uo[8 * h + 7])}; }
                }
            }
        }
    }
}

constexpr int NPH = 2 + 7 * L;
#ifndef DUP
#define DUP -1
#endif
__global__ void __launch_bounds__(NT, 2) mk_fwd(Args args) {
    const int lo = args.ph_lo, hi = args.ph_hi;
    volatile LAS unsigned* misc = (volatile LAS unsigned*)((LAS unsigned char*)lds_raw + LDS_MISC);
    if (threadIdx.x < 16) misc[threadIdx.x] = 0u;
    __syncthreads();
    (void)xcd_barrier_post((unsigned*)(kargs_fresh()->ws + WS_CTL) + CW_BAR, misc);
#define IN(k) (lo <= (k) && (k) < hi)
#define SEAM(k) do { if (IN(k) && IN((k) + 1)) { XcdBarrier xb_; xb_.bar = (unsigned*)(kargs_fresh()->ws + WS_CTL) + CW_BAR; xb_.x = xb_xcc_id(); xb_.st = (volatile LAS unsigned*)((LAS unsigned char*)lds_raw + LDS_MISC); xcd_barrier(xb_); } } while (0)
    const bool owned = (gridDim.x == (unsigned)(M / 256));
#define LSEAM(k) do { if (IN(k) && IN((k) + 1)) { if (owned) { asm volatile("s_waitcnt vmcnt(0)" ::: "memory"); __syncthreads(); } else SEAM(k); } } while (0)
    if (IN(0)) { phase_p0a(); if (DUP == 0) phase_p0a(); }
    SEAM(0);
    if (IN(1)) { phase_p0b(); if (DUP == 1) phase_p0b(); }
    LSEAM(1);
#pragma unroll 1
    for (int l = 0; l < L; ++l) {
        const int pb = 2 + 7 * l;
        if (IN(pb + 0)) { phase_gemm1(l); if (DUP == 2) phase_gemm1(l); }
        SEAM(pb + 0);
        if (IN(pb + 1)) { phase_convpool(l); if (DUP == 3) phase_convpool(l); }
        LSEAM(pb + 1);
        if (IN(pb + 2)) { phase_gemm2(l); if (DUP == 4) phase_gemm2(l); }
        LSEAM(pb + 2);
        if (IN(pb + 3)) { phase_ln1route(l); if (DUP == 5) phase_ln1route(l); }
        SEAM(pb + 3);
        if (IN(pb + 4)) { phase_gemm3(l); if (DUP == 6) phase_gemm3(l); }
        SEAM(pb + 4);
        if (IN(pb + 5)) { phase_gemm4(l); if (DUP == 7) phase_gemm4(l); }
        SEAM(pb + 5);
        if (IN(pb + 6)) { phase_ln2(l); if (DUP == 8) phase_ln2(l); }
        LSEAM(pb + 6);
    }
#undef LSEAM
#undef SEAM
#undef IN
}

extern "C" void kernel_launch(void* const* d_in, const int* in_sizes, int n_in, void* d_out, int out_size, void* d_ws, size_t ws_size, hipStream_t stream) {
    static int grid = 0;
    if (grid == 0) {
        if (n_in != 23 || out_size != M * D || ws_size < WS_END) { fprintf(stderr, "kernel_launch: unexpected shapes (n_in %d out %d ws %zu)\n", n_in, out_size, ws_size); grid = -1; return; }
        int dev = 0, cus = 0;
        if (hipGetDevice(&dev) != hipSuccess || hipDeviceGetAttribute(&cus, hipDeviceAttributeMultiprocessorCount, dev) != hipSuccess) { grid = -1; return; }
        if (hipFuncSetAttribute((const void*)mk_fwd, hipFuncAttributeMaxDynamicSharedMemorySize, LDS_BYTES) != hipSuccess) { fprintf(stderr, "kernel_launch: hipFuncSetAttribute failed\n"); grid = -1; return; }
        int per_cu = 0;
        if (hipOccupancyMaxActiveBlocksPerMultiprocessor(&per_cu, (const void*)mk_fwd, NT, LDS_BYTES) != hipSuccess || per_cu < 1) { fprintf(stderr, "kernel_launch: occupancy query failed (%d)\n", per_cu); (void)hipGetLastError(); grid = -1; return; }
        if (cus != M / 256) { fprintf(stderr, "kernel_launch: built for a %d-CU device (one 256-row tile per workgroup); found %d CUs\n", M / 256, cus); grid = -1; return; }
        if (cus * MOE_MAXU < ((2 * M) / 256 + NE) * 4) { fprintf(stderr, "kernel_launch: %d CUs: more than MOE_MAXU MoE units per workgroup\n", cus); grid = -1; return; }
        grid = cus;
    }
    if (grid < 0) return;
    (void)hipMemsetAsync((char*)d_ws + WS_CTL, 0, CTL_ZERO_BYTES, stream);
    Args a{};
    for (int i = 0; i < 23; ++i) a.in[i] = (const float*)d_in[i];
    a.out = (float*)d_out; a.ws = (unsigned char*)d_ws; a.ph_lo = 0; a.ph_hi = NPH;
    void* kargs[] = {&a};
    const hipError_t e = hipLaunchCooperativeKernel((const void*)mk_fwd, dim3(grid), dim3(NT), kargs, LDS_BYTES, stream);
    if (e != hipSuccess) fprintf(stderr, "kernel_launch: cooperative launch failed: %s (grid %d)\n", hipGetErrorString(e), grid);
}
```

```cpp
#include <hip/hip_runtime.h>
#include <cstdio>
#include <cstdint>

#define GAS __attribute__((address_space(1)))
#define LAS __attribute__((address_space(3)))
typedef unsigned short bf16;
typedef short bf16x8 __attribute__((ext_vector_type(8)));
typedef float f32x4 __attribute__((ext_vector_type(4)));
typedef float f32x2 __attribute__((ext_vector_type(2)));
typedef unsigned u32x4 __attribute__((ext_vector_type(4)));
typedef unsigned u32x2 __attribute__((ext_vector_type(2)));

constexpr int NB = 8, SEQ = 8192, D = 1024, M = NB * SEQ, L = 2;
constexpr int CW = 512, INW = 1536, CK = 31, NE = 32, FE = 512;
constexpr float LN_EPS = 1e-5f;
constexpr float ALPHA = 1.4142135623730951f;
constexpr int NWAVES = 8, NT = 512;
constexpr int LDS_BYTES = 163840;
constexpr int LISTCAP = 65536;

constexpr size_t MiB = 1u << 20;
constexpr size_t WS_CTL = 0, CTL_ZERO_BYTES = 65536;
constexpr size_t WS_MOD = 1 * MiB;
constexpr size_t WS_MODP = 2 * MiB;
constexpr size_t WS_WR = 9 * MiB;
constexpr size_t WS_STATS = 10 * MiB;
constexpr size_t WS_LISTD = 12 * MiB;
constexpr size_t WS_LISTW = 20 * MiB;
constexpr size_t WS_WIN = 28 * MiB;
constexpr size_t WS_WOUT = 34 * MiB;
constexpr size_t WS_WGU = 38 * MiB;
constexpr size_t WS_WD = 166 * MiB;
constexpr size_t WS_A = 232 * MiB;
constexpr size_t WS_B = 360 * MiB;
constexpr size_t WS_C = 504 * MiB;
constexpr size_t WS_D = 632 * MiB;
constexpr size_t WS_E = 888 * MiB;
constexpr size_t WS_PART = 488 * MiB;
constexpr size_t WS_END = 1016 * MiB;
constexpr int CW_CNT = 64;
constexpr int CW_BAR = 1024;
constexpr int LDS_EPIC = 145 * 1024;
constexpr int LDS_OFFS = 134 * 1024;
constexpr int LDS_MISC = 133 * 1024;

#define LDS_WAIT() asm volatile("s_waitcnt lgkmcnt(0)" ::: "memory")
typedef __bf16 bf16v2 __attribute__((ext_vector_type(2)));
typedef _Float16 h16x2 __attribute__((ext_vector_type(2)));
__device__ __forceinline__ unsigned pk2h(float lo, float hi) { return __builtin_bit_cast(unsigned, __builtin_convertvector((f32x2){lo, hi}, h16x2)); }
__device__ __forceinline__ unsigned pk2(float lo, float hi) { return __builtin_bit_cast(unsigned, __builtin_convertvector((f32x2){lo, hi}, bf16v2)); }
__device__ __forceinline__ unsigned f2bf(float f) { return pk2(f, 0.f) & 0xffffu; }
__device__ __forceinline__ float bflo(unsigned u) { return __builtin_bit_cast(float, u << 16); }
__device__ __forceinline__ float bfhi(unsigned u) { return __builtin_bit_cast(float, u & 0xffff0000u); }
__device__ __forceinline__ float bf2f(bf16 b) { return __builtin_bit_cast(float, ((unsigned)b) << 16); }
__device__ __forceinline__ unsigned pk4_fp8(float a, float b, float c, float d) { unsigned r = __builtin_amdgcn_cvt_pk_fp8_f32(a, b, 0u, false); return __builtin_amdgcn_cvt_pk_fp8_f32(c, d, r, true); }
__device__ __forceinline__ float clamp_fp8(float x) { return __builtin_fminf(__builtin_fmaxf(x, -448.0f), 448.0f); }
__device__ __forceinline__ float fmac1(float acc, float a, float b) {
#if defined(__HIP_DEVICE_COMPILE__)
    asm("v_fmac_f32 %0, %1, %2" : "+v"(acc) : "v"(a), "v"(b));
#endif
    return acc;
}
__device__ __forceinline__ float sigmoidf_(float x) { return __builtin_amdgcn_rcpf(1.0f + __builtin_amdgcn_exp2f(x * -1.44269504089f)); }
__device__ __forceinline__ float wave_sum(float v) {
    v += __builtin_bit_cast(float, __builtin_amdgcn_update_dpp(0, __builtin_bit_cast(int, v), 0xB1, 0xf, 0xf, true));
    v += __builtin_bit_cast(float, __builtin_amdgcn_update_dpp(0, __builtin_bit_cast(int, v), 0x4E, 0xf, 0xf, true));
    v += __builtin_bit_cast(float, __builtin_amdgcn_update_dpp(0, __builtin_bit_cast(int, v), 0x141, 0xf, 0xf, true));
    v += __builtin_bit_cast(float, __builtin_amdgcn_update_dpp(0, __builtin_bit_cast(int, v), 0x140, 0xf, 0xf, true));
    const float a = __builtin_bit_cast(float, __builtin_amdgcn_readlane(__builtin_bit_cast(int, v), 0)), b = __builtin_bit_cast(float, __builtin_amdgcn_readlane(__builtin_bit_cast(int, v), 16));
    const float c = __builtin_bit_cast(float, __builtin_amdgcn_readlane(__builtin_bit_cast(int, v), 32)), d = __builtin_bit_cast(float, __builtin_amdgcn_readlane(__builtin_bit_cast(int, v), 48));
    return (a + b) + (c + d);
}

struct Args { const float* in[23]; float* out; unsigned char* ws; int ph_lo, ph_hi; };
enum { I_X = 0, I_C, I_WADA, I_BADA, I_WIN, I_BIN, I_CONVW, I_CONVB, I_CLNG, I_CLNB, I_POOLW, I_POOLS, I_WOUT, I_BOUT, I_LN1G, I_LN1B, I_WR, I_RB, I_WG, I_WU, I_WDN, I_LN2G, I_LN2B };

struct Unit { int pm, pn; };
struct StaticOrder {
    int nM, nN, nwg, G, c;
    __device__ void init(int nM_, int nN_, int G_, int c_) { nM = nM_; nN = nN_; nwg = nM * nN; G = G_; c = c_; }
    __device__ bool next(int i, Unit& u) const {
        const long Lq = (long)i * G + c; if (Lq >= nwg) return false;
        int wgid = (int)Lq; { const int q = nwg / 8, r = nwg % 8, xcd = wgid % 8, off = wgid / 8; wgid = (xcd < r ? xcd * (q + 1) : r * (q + 1) + (xcd - r) * q) + off; }
        const int nig = 8 * nN, gid = wgid / nig, fm = gid * 8, gsz = (nM - fm) < 8 ? (nM - fm) : 8;
        u.pm = fm + ((wgid % nig) % gsz); u.pn = (wgid % nig) / gsz; return true;
    }
};

template <int NM, int NN> struct StaticOrderC {
    int G, c;
    __device__ void init(int, int, int G_, int c_) { G = G_; c = c_; }
    __device__ __forceinline__ bool next(int i, Unit& u) const {
        if (G == NM) { u.pm = c; u.pn = i; return i < NN; }
        constexpr int nwg = NM * NN, q = nwg / 8, r = nwg % 8, nig = 8 * NN;
        const int Lq = i * G + c; if (Lq >= nwg) return false;
        const unsigned w0 = (unsigned)Lq, xcd = w0 % 8u, off = w0 / 8u; const unsigned wgid = (xcd < (unsigned)r ? xcd * (q + 1) : r * (q + 1) + (xcd - r) * q) + off;
        static_assert(NM % 8 == 0, "row-tile groups of 8");
        const unsigned gid = wgid / (unsigned)nig, fm = gid * 8u, rem = wgid % (unsigned)nig;
        u.pm = (int)(fm + rem % 8u); u.pn = (int)(rem / 8u); return true;
    }
};

__device__ __forceinline__ void unpack8(const u32x4 v, float (&e)[8]) { e[0] = bflo(v.x); e[1] = bfhi(v.x); e[2] = bflo(v.y); e[3] = bfhi(v.y); e[4] = bflo(v.z); e[5] = bfhi(v.z); e[6] = bflo(v.w); e[7] = bfhi(v.w); }
__device__ __forceinline__ u32x4 pack8(const float (&o)[8]) { return (u32x4){pk2(o[0], o[1]), pk2(o[2], o[3]), pk2(o[4], o[5]), pk2(o[6], o[7])}; }
#define EPI_ROW(ai, m) ((ai) * 128 + wr * 64 + (m) * 16 + fr)
struct Epi1 {
    bf16* __restrict__ vp; const LAS float* b_in; int row0, pn;
    __device__ __forceinline__ void run(const f32x4 (&acc)[2][2][4][2], int wr, int wc, int fr, int fq) const {
        const int c8 = wc * 32 + 8 * fq;
        if (pn < 4) {
            const int c = pn * 128 + c8; const f32x4 bal = *(const LAS f32x4*)(b_in + c), bah = *(const LAS f32x4*)(b_in + c + 4), bgl = *(const LAS f32x4*)(b_in + 512 + c), bgh = *(const LAS f32x4*)(b_in + 512 + c + 4);
#pragma unroll
            for (int ai = 0; ai < 2; ++ai)
#pragma unroll
                for (int m = 0; m < 4; ++m) { float o[8];
#pragma unroll
                    for (int j = 0; j < 4; ++j) { o[j] = (acc[ai][0][m][0][j] * 0.03125f + bal[j]) * sigmoidf_(acc[ai][1][m][0][j] * 0.03125f + bgl[j]); o[4 + j] = (acc[ai][0][m][1][j] * 0.03125f + bah[j]) * sigmoidf_(acc[ai][1][m][1][j] * 0.03125f + bgh[j]); }
                    *(u32x4*)(vp + (size_t)(row0 + EPI_ROW(ai, m)) * D + c) = (u32x4){pk2h(o[0], o[1]), pk2h(o[2], o[3]), pk2h(o[4], o[5]), pk2h(o[6], o[7])}; }
        } else {
            const int c = (pn - 4) * 256 + c8; const f32x4 b0l = *(const LAS f32x4*)(b_in + 1024 + c), b0h = *(const LAS f32x4*)(b_in + 1024 + c + 4), b1l = *(const LAS f32x4*)(b_in + 1152 + c), b1h = *(const LAS f32x4*)(b_in + 1152 + c + 4);
#pragma unroll
            for (int ai = 0; ai < 2; ++ai)
#pragma unroll
                for (int m = 0; m < 4; ++m) { float o0[8], o1[8];
#pragma unroll
                    for (int j = 0; j < 4; ++j) { o0[j] = acc[ai][0][m][0][j] * 0.03125f + b0l[j]; o0[4 + j] = acc[ai][0][m][1][j] * 0.03125f + b0h[j]; o1[j] = acc[ai][1][m][0][j] * 0.03125f + b1l[j]; o1[4 + j] = acc[ai][1][m][1][j] * 0.03125f + b1h[j]; }
                    bf16* rowp = vp + (size_t)(row0 + EPI_ROW(ai, m)) * D + 512 + c;
                    *(u32x4*)(rowp) = pack8(o0); *(u32x4*)(rowp + 128) = pack8(o1); }
        }
    }
};
struct Epi2 {
    bf16* __restrict__ y; const bf16* __restrict__ xb; const LAS float* bo; const LAS float* gg; float* __restrict__ part; int row0, pn;
    __device__ __forceinline__ void rows(const f32x4 (&acc)[2][2][4][2], const int ai, const u32x4 (&xr)[4][2], const int c8, u32x4 (&out)[4][2], f32x2 (&st)[4]) const {
#pragma unroll
        for (int m = 0; m < 4; ++m) { float s = 0.f, q = 0.f;
#pragma unroll
            for (int h = 0; h < 2; ++h) { const int c = pn * 256 + h * 128 + c8;
                const f32x4 b0 = *(const LAS f32x4*)(bo + c), b1 = *(const LAS f32x4*)(bo + c + 4), g0 = *(const LAS f32x4*)(gg + c), g1v = *(const LAS f32x4*)(gg + c + 4);
                float x8[8]; unpack8(xr[m][h], x8); float o[8];
#pragma unroll
                for (int j = 0; j < 4; ++j) { o[j] = ALPHA * x8[j] + g0[j] * (acc[ai][h][m][0][j] * 0.015625f + b0[j]); o[4 + j] = ALPHA * x8[4 + j] + g1v[j] * (acc[ai][h][m][1][j] * 0.015625f + b1[j]); }
                out[m][h] = pack8(o); float e[8]; unpack8(out[m][h], e);
#pragma unroll
                for (int j = 0; j < 8; ++j) { s += e[j]; q += e[j] * e[j]; } }
            st[m] = (f32x2){s, q}; }
#pragma unroll
        for (int m = 0; m < 4; ++m) { st[m].x += __shfl_xor(st[m].x, 16); st[m].y += __shfl_xor(st[m].y, 16); }
#pragma unroll
        for (int m = 0; m < 4; ++m) { st[m].x += __shfl_xor(st[m].x, 32); st[m].y += __shfl_xor(st[m].y, 32); }
    }
    __device__ __forceinline__ void run(const f32x4 (&acc)[2][2][4][2], int wr, int wc, int fr, int fq) const {
        const int c8 = wc * 32 + 8 * fq;
        u32x4 xr[4][2], xr1[4][2], out[4][2]; f32x2 st[4];
#pragma unroll
        for (int m = 0; m < 4; ++m)
#pragma unroll
            for (int h = 0; h < 2; ++h) xr[m][h] = __builtin_nontemporal_load((const u32x4*)(xb + (size_t)(row0 + EPI_ROW(0, m)) * D + pn * 256 + h * 128 + c8));
        rows(acc, 0, xr, c8, out, st);
#pragma unroll
        for (int m = 0; m < 4; ++m)
#pragma unroll
            for (int h = 0; h < 2; ++h) xr1[m][h] = __builtin_nontemporal_load((const u32x4*)(xb + (size_t)(row0 + EPI_ROW(1, m)) * D + pn * 256 + h * 128 + c8));
        asm volatile("" ::: "memory");
#pragma unroll
        for (int m = 0; m < 4; ++m) { const size_t ro = (size_t)(row0 + EPI_ROW(0, m)) * D;
            *(u32x4*)(y + ro + pn * 256 + c8) = out[m][0]; *(u32x4*)(y + ro + pn * 256 + 128 + c8) = out[m][1];
            if (fq == 0) *(f32x2*)(part + ((size_t)(pn * 4 + wc) * M + row0 + EPI_ROW(0, m)) * 2) = st[m]; }
        rows(acc, 1, xr1, c8, out, st);
#pragma unroll
        for (int m = 0; m < 4; ++m) { const size_t ro = (size_t)(row0 + EPI_ROW(1, m)) * D;
            *(u32x4*)(y + ro + pn * 256 + c8) = out[m][0]; *(u32x4*)(y + ro + pn * 256 + 128 + c8) = out[m][1];
            if (fq == 0) *(f32x2*)(part + ((size_t)(pn * 4 + wc) * M + row0 + EPI_ROW(1, m)) * 2) = st[m]; }
    }
};
__device__ __forceinline__ u32x4 pair16(const u32x2 v0, const u32x2 v1, const bool odd) {
    const u32x2 keep = odd ? v1 : v0, send = odd ? v0 : v1; u32x2 recv; recv.x = __shfl_xor(send.x, 16); recv.y = __shfl_xor(send.y, 16);
    return odd ? (u32x4){recv.x, recv.y, keep.x, keep.y} : (u32x4){keep.x, keep.y, recv.x, recv.y};
}
struct Epi3 {
    unsigned char* __restrict__ hm; int row0, pn;
    __device__ __forceinline__ void run(const f32x4 (&acc)[2][2][4][2], int wr, int wc, int fr, int fq) const {
        const bool odd = fq & 1; const int cb = wc * 32 + 16 * (fq >> 1);
#pragma unroll
        for (int ai = 0; ai < 2; ++ai) {
            u32x2 v[4];
#pragma unroll
            for (int m = 0; m < 4; ++m) { float o[8];
#pragma unroll
                for (int j = 0; j < 4; ++j) { const float g0 = acc[ai][0][m][0][j] * 0.015625f, g1 = acc[ai][0][m][1][j] * 0.015625f; o[j] = clamp_fp8(g0 * sigmoidf_(g0) * (acc[ai][1][m][0][j] * 0.015625f)); o[4 + j] = clamp_fp8(g1 * sigmoidf_(g1) * (acc[ai][1][m][1][j] * 0.015625f)); }
                v[m] = (u32x2){pk4_fp8(o[0], o[1], o[2], o[3]), pk4_fp8(o[4], o[5], o[6], o[7])}; }
#pragma unroll
            for (int pr = 0; pr < 2; ++pr) { const u32x4 w = pair16(v[2 * pr], v[2 * pr + 1], odd); const int r = odd ? EPI_ROW(ai, 2 * pr + 1) : EPI_ROW(ai, 2 * pr);
                *(u32x4*)(hm + (size_t)(row0 + r) * FE + pn * 128 + cb) = w; }
        }
    }
};
#define EPI4_BODY(DD, WW) do { const bool odd = fq & 1; const int cb = wc * 32 + 16 * (fq >> 1); \
        _Pragma("unroll") for (int ai = 0; ai < 2; ++ai) \
            _Pragma("unroll") for (int pr = 0; pr < 2; ++pr) { int dd[2]; float ww[2]; u32x2 v[2][2]; \
                _Pragma("unroll") for (int mm = 0; mm < 2; ++mm) { const int r = EPI_ROW(ai, 2 * pr + mm); dd[mm] = DD; ww[mm] = WW; } \
                _Pragma("unroll") for (int mm = 0; mm < 2; ++mm) { const int m = 2 * pr + mm; const float w = ww[mm]; float o0[8], o1[8]; \
                    _Pragma("unroll") for (int j = 0; j < 4; ++j) { o0[j] = clamp_fp8(w * acc[ai][0][m][0][j]); o0[4 + j] = clamp_fp8(w * acc[ai][0][m][1][j]); o1[j] = clamp_fp8(w * acc[ai][1][m][0][j]); o1[4 + j] = clamp_fp8(w * acc[ai][1][m][1][j]); } \
                    v[0][mm] = (u32x2){pk4_fp8(o0[0], o0[1], o0[2], o0[3]), pk4_fp8(o0[4], o0[5], o0[6], o0[7])}; v[1][mm] = (u32x2){pk4_fp8(o1[0], o1[1], o1[2], o1[3]), pk4_fp8(o1[4], o1[5], o1[6], o1[7])}; } \
                const int d = odd ? dd[1] : dd[0]; \
                _Pragma("unroll") for (int h = 0; h < 2; ++h) { const u32x4 w4 = pair16(v[h][0], v[h][1], odd); if (d >= 0) *(u32x4*)(ct + (size_t)d * D + pn * 256 + h * 128 + cb) = w4; } } } while (0)
template <int AS> struct Epi4;
template <> struct Epi4<3> {
    unsigned char* __restrict__ ct; const LAS int* ld; const LAS float* lw; int pn;
    __device__ __forceinline__ void run(const f32x4 (&acc)[2][2][4][2], int wr, int wc, int fr, int fq) const { EPI4_BODY(ld[r], lw[r]); }
};
struct Epi4G {
    unsigned char* __restrict__ ct; const int* __restrict__ ld; const float* __restrict__ lw; int nvalid, pn;
    __device__ __forceinline__ void run(const f32x4 (&acc)[2][2][4][2], int wr, int wc, int fr, int fq) const { EPI4_BODY((r < nvalid ? ld[r] : -1), (r < nvalid ? lw[r] * 0.25f : 0.f)); }
};
#undef EPI_ROW

namespace pg8 {
constexpr int BM = 256, BK = 64, HALF = 128, HTB = HALF * BK * 2, STAGE_BYTES = 8 * HTB;
__device__ __forceinline__ int lds_byte(int r, int c) { const int st = (r >> 4) * 2 + (c >> 5), rr = r & 15, cc = c & 31, ob = rr * 64 + cc * 2; return st * 1024 + (ob ^ (((ob >> 9) & 1) << 4)); }
__device__ __forceinline__ void stage_rc(int b, int& R, int& C) { const int st = b / 1024, sb = b % 1024, swz = sb ^ (((sb >> 9) & 1) << 4); R = (st >> 1) * 16 + swz / 64; C = (st & 1) * 32 + (swz % 64) / 2; }
__device__ __forceinline__ int perm32(int rho) { const int n = rho >> 4, i = rho & 15; return 8 * (i >> 2) + 4 * n + (i & 3); }

typedef int i32x8 __attribute__((ext_vector_type(8)));
typedef unsigned u32x8 __attribute__((ext_vector_type(8)));
template <bool FP8> struct Frag;
template <> struct Frag<false> { u32x4 v[2]; };
template <> struct Frag<true> { i32x8 v; };
template <bool FP8> __device__ __forceinline__ Frag<FP8> ld_frag(const LAS unsigned char* p, const LAS unsigned char* p2) {
    Frag<FP8> f;
    if constexpr (FP8) { const u32x4 a = *(const LAS u32x4*)p, b = *(const LAS u32x4*)p2; f.v = __builtin_bit_cast(i32x8, __builtin_shufflevector(a, b, 0, 1, 2, 3, 4, 5, 6, 7)); }
    else { f.v[0] = *(const LAS u32x4*)p; f.v[1] = *(const LAS u32x4*)(p + 1024); }
    return f;
}
template <bool FP8> __device__ __forceinline__ f32x4 mma_frag(const Frag<FP8>& b, const Frag<FP8>& a, f32x4 acc) {
#if defined(__HIP_DEVICE_COMPILE__)
    if constexpr (FP8) { asm volatile("v_mfma_f32_16x16x128_f8f6f4 %0, %1, %2, %0" : "+v"(acc) : "v"(b.v), "v"(a.v)); return acc; }
#else
    if constexpr (FP8) return acc;
#endif
    else { acc = __builtin_amdgcn_mfma_f32_16x16x32_bf16(__builtin_bit_cast(bf16x8, b.v[0]), __builtin_bit_cast(bf16x8, a.v[0]), acc, 0, 0, 0);
           return __builtin_amdgcn_mfma_f32_16x16x32_bf16(__builtin_bit_cast(bf16x8, b.v[1]), __builtin_bit_cast(bf16x8, a.v[1]), acc, 0, 0, 0); }
}
template <class Prob, bool ALIGN_EPI, bool FP8 = false>
__device__ __forceinline__ void gemm_phase(LAS unsigned char* lds, const Prob& P, const int tid) {
    const int wid = __builtin_amdgcn_readfirstlane(tid >> 6), lane = tid & 63, wr = wid >> 2, wc = wid & 3, fr = lane & 15, fq = lane >> 4;
    const int K = P.K, RB = FP8 ? K : 2 * K, nt = RB / 128;
    unsigned voffB[2];
#pragma unroll
    for (int i = 0; i < 2; ++i) { int R, C; stage_rc(tid * 16 + i * 8192, R, C); const int Rb = (R & ~31) + perm32(R & 31); voffB[i] = (unsigned)(Rb * RB + C * 2); }
    const size_t kstep = (size_t)(BK * 2);
    const size_t hstepB = (size_t)HALF * RB;
    const unsigned ldsw = (unsigned)wid * 1024u;
    const int fcol = FP8 ? ((fq >> 1) * 32 + (fq & 1) * 16) : fq * 8;
    const int aoff = lds_byte(wr * 64 + fr, fcol), boff = lds_byte(wc * 32 + fr, fcol), d16 = (fr & 8) ? -16 : 16;
#define PG8_SA(b, h) (((b) * 2 + (h)) * HTB)
#define PG8_SB(b, h) ((4 + (b) * 2 + (h)) * HTB)
#define PG8_STAGE2(bufoff, gbase, o0, o1) do { \
        __builtin_amdgcn_global_load_lds((const unsigned*)((const char*)(gbase) + (o0)), (LAS unsigned*)(lds + (bufoff) + ldsw), 16, 0, 0); \
        __builtin_amdgcn_global_load_lds((const unsigned*)((const char*)(gbase) + (o1)), (LAS unsigned*)(lds + (bufoff) + ldsw + 8192), 16, 0, 0); } while (0)
#define PG8_STAGEB(bufoff, gbase) PG8_STAGE2(bufoff, gbase, voffB[0], voffB[1])
#define PG8_STAGEA1(bufoff, gbase) do { if constexpr (Prob::GATHER) { PG8_STAGE2(bufoff, gbase, c10, c11); } else { PG8_STAGE2(bufoff, (gbase) + hstepA, c00, c01); } } while (0)
#define PG8_LDA(dst, b, h) do { _Pragma("unroll") for (int m = 0; m < 4; ++m) dst[m] = ld_frag<FP8>(lds + PG8_SA(b, h) + aoff + m * 2048, lds + PG8_SA(b, h) + aoff + m * 2048 + d16); } while (0)
#define PG8_LDB(dst, b, h) do { _Pragma("unroll") for (int n = 0; n < 2; ++n) dst[n] = ld_frag<FP8>(lds + PG8_SB(b, h) + boff + n * 2048, lds + PG8_SB(b, h) + boff + n * 2048 + d16); } while (0)
#define PG8_MMA(ai, bj, At, Bt) do { __builtin_amdgcn_s_setprio(1); _Pragma("unroll") for (int m = 0; m < 4; ++m) _Pragma("unroll") for (int n = 0; n < 2; ++n) \
        acc[ai][bj][m][n] = mma_frag<FP8>(Bt[n], At[m], acc[ai][bj][m][n]); __builtin_amdgcn_s_setprio(0); } while (0)
#define PG8_WAIT_V(n) asm volatile("s_waitcnt vmcnt(" #n ")" ::: "memory")
#define PG8_WAIT_L(n) asm volatile("s_waitcnt lgkmcnt(" #n ")" ::: "memory")
#define PG8_BAR __builtin_amdgcn_s_barrier()
#define PG8_SCHED __builtin_amdgcn_sched_barrier(0)
    Unit cur, nxt; int ui = 0;
    if (!P.next(0, cur)) return;
    f32x4 acc[2][2][4][2];
#pragma unroll
    for (int a = 0; a < 2; ++a)
#pragma unroll
        for (int b = 0; b < 2; ++b)
#pragma unroll
            for (int m = 0; m < 4; ++m)
#pragma unroll
                for (int n = 0; n < 2; ++n) acc[a][b][m][n] = (f32x4){0.f, 0.f, 0.f, 0.f};
    Frag<FP8> At[4], B0[2], B1[2];
    const size_t hstepA = Prob::GATHER ? (size_t)0 : (size_t)HALF * RB;
    const char* cA; const char* cB; unsigned c00, c01, c10, c11;
    P.resolve(cur, 0, cA, cB, c00, c01, c10, c11);
    PG8_STAGEB(PG8_SB(0, 0), cB); PG8_STAGEB(PG8_SB(0, 1), cB + hstepB); PG8_STAGE2(PG8_SA(0, 0), cA, c00, c01); PG8_STAGEA1(PG8_SA(0, 1), cA);
    if (wr == 1) PG8_BAR;
    PG8_WAIT_V(2); PG8_BAR;
    PG8_STAGEB(PG8_SB(1, 0), cB + kstep); PG8_STAGE2(PG8_SA(1, 0), cA + kstep, c00, c01); PG8_STAGEB(PG8_SB(1, 1), cB + hstepB + kstep);
    PG8_WAIT_V(6); PG8_BAR;
    for (;;) {
        const bool has_next = P.next(ui + 1, nxt);
        const char* nA = cA; const char* nB = cB;
        if (has_next) { unsigned n00, n01, n10, n11; P.resolve(nxt, ui + 1, nA, nB, n00, n01, n10, n11); if constexpr (Prob::GATHER) *(LAS u32x4*)(lds + LDS_OFFS + tid * 16) = (u32x4){n00, n01, n10, n11}; }
        for (int t = 0; t < nt; t += 2) {
            const bool last = (t == nt - 2);
            const char* a1 = cA + (size_t)(t + 1) * kstep;
            const char* a2 = last ? nA : cA + (size_t)(t + 2) * kstep; const char* b2 = last ? nB : cB + (size_t)(t + 2) * kstep;
            const char* a3 = a2 + kstep; const char* b3 = b2 + kstep;
            PG8_LDB(B0, 0, 0); PG8_LDB(B1, 0, 1); PG8_SCHED; PG8_LDA(At, 0, 0); PG8_STAGEA1(PG8_SA(1, 1), a1);
            if constexpr (Prob::GATHER) { if (last && has_next) { const u32x4 o = *(const LAS u32x4*)(lds + LDS_OFFS + tid * 16); c00 = o.x; c01 = o.y; c10 = o.z; c11 = o.w; } }
            PG8_WAIT_V(8); PG8_WAIT_L(0); PG8_BAR; PG8_MMA(0, 0, At, B0); PG8_MMA(0, 1, At, B1); PG8_BAR; PG8_SCHED;
            PG8_LDA(At, 0, 1); PG8_STAGEB(PG8_SB(0, 0), b2); PG8_STAGEB(PG8_SB(0, 1), b2 + hstepB); PG8_STAGE2(PG8_SA(0, 0), a2, c00, c01);
            PG8_WAIT_V(8); PG8_WAIT_L(0); PG8_BAR; PG8_MMA(1, 0, At, B0); PG8_MMA(1, 1, At, B1); PG8_BAR; PG8_SCHED;
            PG8_LDB(B0, 1, 0); PG8_LDB(B1, 1, 1); PG8_SCHED; PG8_LDA(At, 1, 0); PG8_STAGEA1(PG8_SA(0, 1), a2);
            PG8_WAIT_V(8); PG8_WAIT_L(0); PG8_BAR; PG8_MMA(0, 0, At, B0); PG8_MMA(0, 1, At, B1); PG8_BAR; PG8_SCHED;
            PG8_LDA(At, 1, 1); PG8_STAGEB(PG8_SB(1, 0), b3); PG8_STAGEB(PG8_SB(1, 1), b3 + hstepB); PG8_STAGE2(PG8_SA(1, 0), a3, c00, c01);
            PG8_WAIT_V(8); PG8_WAIT_L(0); PG8_BAR; PG8_MMA(1, 0, At, B0); PG8_MMA(1, 1, At, B1); PG8_BAR; PG8_SCHED;
        }
        if constexpr (ALIGN_EPI) { if (wr == 0) PG8_BAR; }
        P.epi(cur, ui, acc, wr, wc, fr, fq);
        if (!has_next) break;
#pragma unroll
        for (int a = 0; a < 2; ++a)
#pragma unroll
            for (int b = 0; b < 2; ++b)
#pragma unroll
                for (int m = 0; m < 4; ++m)
#pragma unroll
                    for (int n = 0; n < 2; ++n) acc[a][b][m][n] = (f32x4){0.f, 0.f, 0.f, 0.f};
        cur = nxt; cA = nA; cB = nB; ++ui;
        if constexpr (ALIGN_EPI) { if (wr == 1) PG8_BAR; }
    }
    PG8_WAIT_V(0);
    if constexpr (!ALIGN_EPI) { if (wr == 0) PG8_BAR; }
    PG8_BAR;
#undef PG8_STAGEA1
#undef PG8_SA
#undef PG8_SB
#undef PG8_STAGE2
#undef PG8_STAGEB
#undef PG8_LDA
#undef PG8_LDB
#undef PG8_MMA
#undef PG8_WAIT_V
#undef PG8_WAIT_L
#undef PG8_BAR
#undef PG8_SCHED
}
__device__ __forceinline__ void lin_offsets(int tid, int RB, unsigned& o00, unsigned& o01, unsigned& o10, unsigned& o11) {
    int R0, C0, R1, C1; stage_rc(tid * 16, R0, C0); stage_rc(tid * 16 + 8192, R1, C1);
    o00 = (unsigned)(R0 * RB + C0 * 2); o01 = (unsigned)(R1 * RB + C1 * 2); o10 = (unsigned)((R0 + HALF) * RB + C0 * 2); o11 = (unsigned)((R1 + HALF) * RB + C1 * 2);
}
template <class E>
__device__ __forceinline__ void run_epi(const E& e, const f32x4 (&acc)[2][2][4][2], int wr, int wc, int fr, int fq) { e.run(acc, wr, wc, fr, fq); }
}

struct Frame { LAS unsigned char* lds; int tid, lane, wave, G, bid; };
extern __shared__ __attribute__((aligned(16))) unsigned char lds_raw[];
__device__ __forceinline__ Frame make_frame() { Frame F; int t = threadIdx.x; asm volatile("" : "+v"(t)); F.lds = (LAS unsigned char*)lds_raw; F.tid = t; F.lane = t & 63; F.wave = __builtin_amdgcn_readfirstlane(t >> 6); F.G = gridDim.x; F.bid = blockIdx.x; return F; }
typedef const __attribute__((address_space(4))) Args* KArgs;
__device__ __forceinline__ KArgs kargs_fresh() { KArgs p = (KArgs)__builtin_amdgcn_kernarg_segment_ptr(); asm volatile("" : "+s"(p)); return p; }


#define XB_TMO      128
#define XB_XCNT(j)  (256  + 64 * (j))
#define XB_XSUB(j)  (1280 + 64 * (j))
#define XB_XGEN(j)  (2304 + 64 * (j))
#define XB_TOP      3328
#define XB_TOPGEN   3392
#define XCD_BAR_WORDS 3456
#define XB_SPIN_CAP (1u << 18)
__device__ __forceinline__ unsigned xb_ld(unsigned* p)              { return __hip_atomic_load(p, __ATOMIC_RELAXED, __HIP_MEMORY_SCOPE_AGENT); }
__device__ __forceinline__ unsigned xb_add(unsigned* p, unsigned v) { return __hip_atomic_fetch_add(p, v, __ATOMIC_RELAXED, __HIP_MEMORY_SCOPE_AGENT); }
__device__ __forceinline__ unsigned xb_xcc_id() { return (unsigned)__builtin_amdgcn_s_getreg((3 << 11) | 20) & 0xFu; }
#define XB_SPIN(cond, bar) do { unsigned _sp = 0; while (cond) { __builtin_amdgcn_s_sleep(1); \
    if ((++_sp & 255u) == 0u) { if (xb_ld(&(bar)[XB_TMO])) break; if (_sp > XB_SPIN_CAP) { atomicAdd(&(bar)[XB_TMO], 1u); break; } } } } while (0)
struct XcdBarrier { unsigned* bar; unsigned x; volatile LAS unsigned* st; };
__device__ __forceinline__ XcdBarrier xcd_barrier_post(unsigned* bar, volatile LAS unsigned* st) {
    XcdBarrier b; b.bar = bar; b.x = xb_xcc_id(); b.st = st;
    if (threadIdx.x == 0) (void)xb_add(&bar[XB_XCNT(b.x)], 1u);
    return b;
}
__device__ __forceinline__ void xcd_barrier_complete(unsigned* bar, unsigned x, unsigned& nloc, unsigned& nx) {
    const unsigned G = gridDim.x * gridDim.y * gridDim.z;
    unsigned sum, cnt, mine, sp = 0u;
    for (;;) {
        sum = 0u; cnt = 0u; mine = 0u;
#pragma unroll
        for (unsigned j = 0; j < 16; ++j) { const unsigned c = xb_ld(&bar[XB_XCNT(j)]); sum += c; cnt += (c > 0u) ? 1u : 0u; mine = (j == x) ? c : mine; }
        if (sum == G) break;
        __builtin_amdgcn_s_sleep(1);
        if ((++sp & 255u) == 0u) { if (xb_ld(&bar[XB_TMO])) break; if (sp > XB_SPIN_CAP) { atomicAdd(&bar[XB_TMO], 1u); break; } }
    }
    nloc = mine > 0u ? mine : 1u; nx = cnt > 0u ? cnt : 1u;
}
__device__ __forceinline__ void xcd_barrier(const XcdBarrier& b) {
    asm volatile("s_waitcnt vmcnt(0)" ::: "memory");
    __syncthreads();
    if (threadIdx.x == 0) {
        unsigned* bar = b.bar;
        __builtin_amdgcn_s_waitcnt(0);
        unsigned nloc = b.st[0], nx = b.st[1];
        if (nloc == 0u) { xcd_barrier_complete(bar, b.x, nloc, nx); b.st[0] = nloc; b.st[1] = nx; }
        const unsigned old = xb_add(&bar[XB_XSUB(b.x)], 1u);
        const unsigned gen = old / nloc;
        if (old + 1u == (gen + 1u) * nloc) {
            __builtin_amdgcn_fence(__ATOMIC_RELEASE, "agent");
            asm volatile("s_waitcnt vmcnt(0)" ::: "memory");
            const unsigned og = xb_add(&bar[XB_TOP], 1u);
            const unsigned tg = og / nx;
            if (og + 1u == (tg + 1u) * nx) xb_add(&bar[XB_TOPGEN], 1u);
            else XB_SPIN(xb_ld(&bar[XB_TOPGEN]) == tg, bar);
            __builtin_amdgcn_fence(__ATOMIC_ACQUIRE, "agent");
            xb_add(&bar[XB_XGEN(b.x)], 1u);
            asm volatile("s_waitcnt vmcnt(0)" ::: "memory");
        } else {
            XB_SPIN(xb_ld(&bar[XB_XGEN(b.x)]) == gen, bar);
            __builtin_amdgcn_fence(__ATOMIC_ACQUIRE, "agent");
            asm volatile("s_waitcnt vmcnt(0)" ::: "memory");
        }
    }
    __syncthreads();
}

__device__ __forceinline__ int drow_map(int kind, int n) {
    if (kind == 0) return n;
    if (kind == 1) { if (n < 512) return ((n >> 7) << 8) + (n & 127); if (n < 1024) { const int c = n - 512; return ((c >> 7) << 8) + 128 + (c & 127); } return n; }
    if (kind == 2) return ((n >> 7) << 8) + (n & 127);
    return ((n >> 7) << 8) + 128 + (n & 127);
}
__device__ __forceinline__ void p0_transpose_item(const float* W, int N, bf16* WT, int Kd, int kind, int nblk, int item, LAS float* scr, int lane) {
    const int kb = item / nblk, nb = item % nblk, k0 = 64 * kb, n0 = 32 * nb;
#pragma unroll 8
    for (int i = 0; i < 32; ++i) { const int kk = 2 * i + (lane >> 5); scr[kk * 33 + (lane & 31)] = __builtin_nontemporal_load(W + (size_t)(k0 + kk) * N + n0 + (lane & 31)); }
    LDS_WAIT();
    const int c = lane & 7;
#pragma unroll
    for (int j = 0; j < 4; ++j) { const int n = (lane >> 3) + 8 * j; const LAS float* s = scr + (8 * c) * 33 + n;
        u32x4 o; o.x = pk2(s[0 * 33], s[1 * 33]); o.y = pk2(s[2 * 33], s[3 * 33]); o.z = pk2(s[4 * 33], s[5 * 33]); o.w = pk2(s[6 * 33], s[7 * 33]);
        *(u32x4*)(WT + (size_t)drow_map(kind, n0 + n) * Kd + k0 + 8 * c) = o; }
    LDS_WAIT();
}
__device__ __forceinline__ void p0_transpose_item_f8(const float* W, int N, unsigned char* WT, int Kd, int kind, int nblk, int item, LAS float* scr, int lane, const float wscale = 64.0f) {
    const int kb = item / nblk, nb = item % nblk, k0 = 64 * kb, n0 = 32 * nb;
#pragma unroll 8
    for (int i = 0; i < 32; ++i) { const int kk = 2 * i + (lane >> 5); scr[kk * 33 + (lane & 31)] = __builtin_nontemporal_load(W + (size_t)(k0 + kk) * N + n0 + (lane & 31)) * wscale; }
    LDS_WAIT();
    const int c = lane & 7;
#pragma unroll
    for (int j = 0; j < 4; ++j) { const int n = (lane >> 3) + 8 * j; const LAS float* s = scr + (8 * c) * 33 + n;
        *(u32x2*)(WT + (size_t)drow_map(kind, n0 + n) * Kd + k0 + 8 * c) = (u32x2){pk4_fp8(s[0 * 33], s[1 * 33], s[2 * 33], s[3 * 33]), pk4_fp8(s[4 * 33], s[5 * 33], s[6 * 33], s[7 * 33])}; }
    LDS_WAIT();
}
__device__ __forceinline__ void phase_p0a() {
    const Frame F = make_frame();
    const KArgs ka = kargs_fresh(); unsigned char* const ws = ka->ws;
    bf16* Win_t = (bf16*)(ws + WS_WIN); bf16* Wout_t = (bf16*)(ws + WS_WOUT); unsigned char* Wgu_t = ws + WS_WGU; unsigned char* Wd_t = ws + WS_WD;
    {
        LAS float* scr = (LAS float*)(F.lds + F.wave * 16384);
        const int gw = F.bid * NWAVES + F.wave, NGW = F.G * NWAVES;
        constexpr int N_EXP = 64 * 768, N_IN = 2 * 768, N_OUT = 2 * 256;
        for (int it = gw; it < N_EXP + N_IN + N_OUT; it += NGW) {
            if (it < N_EXP) {
                const int le = it / 768, r = it % 768;
                if (r < 256) p0_transpose_item_f8(ka->in[I_WG] + (size_t)le * D * FE, FE, Wgu_t + (size_t)le * D * D, D, 2, 16, r, scr, F.lane);
                else if (r < 512) p0_transpose_item_f8(ka->in[I_WU] + (size_t)le * D * FE, FE, Wgu_t + (size_t)le * D * D, D, 3, 16, r - 256, scr, F.lane);
                else p0_transpose_item_f8(ka->in[I_WDN] + (size_t)le * FE * D, D, Wd_t + (size_t)le * D * FE, FE, 0, 32, r - 512, scr, F.lane);
            } else if (it < N_EXP + N_IN) {
                const int r0 = it - N_EXP, l = r0 / 768, r = r0 % 768;
                p0_transpose_item_f8(ka->in[I_WIN] + (size_t)l * D * INW, INW, (unsigned char*)Win_t + (size_t)l * INW * D, D, 1, 48, r, scr, F.lane, 32.0f);
            } else {
                const int r0 = it - N_EXP - N_IN, l = r0 / 256, r = r0 % 256;
                p0_transpose_item_f8(ka->in[I_WOUT] + (size_t)l * D * D, D, (unsigned char*)Wout_t + (size_t)l * D * D, D, 0, 32, r, scr, F.lane, 64.0f);
            }
        }
    }
    __syncthreads();
    {
        LAS float* pws = (LAS float*)F.lds;
        LAS float* wo = (LAS float*)(F.lds + 128 * 129 * 4);
        for (int item = F.bid; item < 256; item += F.G) {
            const int l = item >> 7, g = (item >> 5) & 3, n0 = (item & 31) * 32;
            const float* pw = ka->in[I_POOLW] + (size_t)(l * 4 + g) * 128 * 128; const float* ps = ka->in[I_POOLS] + l * 512 + g * 128;
            const float* wout = ka->in[I_WOUT] + (size_t)l * D * D + (size_t)(512 + g * 128) * D;
            for (int i = 0; i < 32; ++i) { const int idx = F.tid + 512 * i, c = idx >> 7, d = idx & 127; pws[c * 129 + d] = pw[idx] * ps[d]; }
            for (int i = 0; i < 8; ++i) { const int idx = F.tid + 512 * i, d = idx >> 5, nn = idx & 31; wo[idx] = wout[(size_t)d * D + n0 + nn]; }
            __syncthreads();
            const int c = F.tid & 127, nq = F.tid >> 7;
            float acc[8];
#pragma unroll
            for (int i = 0; i < 8; ++i) acc[i] = 0.f;
#pragma unroll 1
            for (int d0 = 0; d0 < 128; d0 += 8) {
                float a[8]; f32x4 wl[8], wh[8];
#pragma unroll
                for (int dd = 0; dd < 8; ++dd) { a[dd] = pws[c * 129 + d0 + dd]; wl[dd] = *(const LAS f32x4*)(wo + (d0 + dd) * 32 + nq * 8); wh[dd] = *(const LAS f32x4*)(wo + (d0 + dd) * 32 + nq * 8 + 4); }
#pragma unroll
                for (int dd = 0; dd < 8; ++dd)
#pragma unroll
                    for (int i = 0; i < 4; ++i) { acc[i] += a[dd] * wl[dd][i]; acc[4 + i] += a[dd] * wh[dd][i]; }
            }
#pragma unroll
            for (int i = 0; i < 8; ++i) ((unsigned char*)Wout_t)[(size_t)l * D * D + (size_t)(n0 + nq * 8 + i) * D + 512 + g * 128 + c] = (unsigned char)(pk4_fp8(acc[i] * 64.0f, 0.f, 0.f, 0.f) & 0xffu);
            __syncthreads();
        }
    }
    {
        LAS float* cact = (LAS float*)F.lds;
        float* modp = (float*)(ws + WS_MODP);
        for (int item = F.bid; item < 384; item += F.G) {
            const int l = item / 192, r = item % 192, kc = r / 12, jc = r % 12, k0 = kc * 64, j = jc * 512 + F.tid;
            { const int b = F.tid >> 6, kk = F.tid & 63; const float cv = ka->in[I_C][b * D + k0 + kk]; cact[F.tid] = cv * sigmoidf_(cv); }
            __syncthreads();
            float acc[8];
#pragma unroll
            for (int b = 0; b < 8; ++b) acc[b] = 0.f;
            const float* wp = ka->in[I_WADA] + (size_t)l * D * 6 * D + (size_t)k0 * 6 * D + j;
#pragma unroll 8
            for (int kk = 0; kk < 64; ++kk) { const float w = __builtin_nontemporal_load(wp + (size_t)kk * 6 * D);
#pragma unroll
                for (int b = 0; b < 8; ++b) acc[b] += cact[b * 64 + kk] * w; }
#pragma unroll
            for (int b = 0; b < 8; ++b) modp[((size_t)(kc * L + l) * NB + b) * 6 * D + j] = acc[b];
            __syncthreads();
        }
    }
    {
        bf16* hi = (bf16*)(ws + WS_WR); bf16* lo = hi + NE * D;
        for (int idx = F.bid * NT + F.tid; idx < NE * D; idx += F.G * NT) { const int e = idx >> 10, k = idx & 1023; const float v = ka->in[I_WR][k * NE + e];
            const unsigned h = f2bf(v); hi[idx] = (bf16)h; lo[idx] = (bf16)f2bf(v - bflo(h)); }
    }
}

__device__ __forceinline__ float mod_sum(const float* modp, const float* bada, int l, int b, int j) {
    float s = bada[l * 6 * D + j];
#pragma unroll
    for (int kc = 0; kc < 16; ++kc) s += modp[((size_t)(kc * L + l) * NB + b) * 6 * D + j];
    return s;
}
__device__ __forceinline__ void phase_p0b() {
    const Frame F = make_frame();
    const KArgs ka = kargs_fresh(); unsigned char* const ws = ka->ws;
    float* mod = (float*)(ws + WS_MOD); const float* modp = (const float*)(ws + WS_MODP); const float* bada = ka->in[I_BADA];
    for (int idx = F.bid * NT + F.tid; idx < L * NB * 6 * D; idx += F.G * NT) { const int l = idx / (NB * 6 * D), rem = idx % (NB * 6 * D), b = rem / (6 * D), j = rem % (6 * D); mod[idx] = mod_sum(modp, bada, l, b, j); }
    LAS float* sh = (LAS float*)F.lds; LAS float* sc = sh + D;
    unsigned char* __restrict__ uq = ws + WS_A; bf16* __restrict__ xbo = (bf16*)(ws + WS_E);
    const float* __restrict__ xin = ka->in[I_X];
    for (int chunk = F.bid; chunk < M / 256; chunk += F.G) {
        const int b = chunk >> 5;
        __syncthreads();
        for (int i = F.tid; i < 2 * D; i += NT) { const float s = mod_sum(modp, bada, 0, b, i); if (i < D) sh[i] = s; else sc[i - D] = 1.0f + s; }
        __syncthreads();
#pragma unroll 2
        for (int rr = 0; rr < 32; ++rr) {
            const size_t row = (size_t)chunk * 256 + F.wave * 32 + rr;
            f32x4 xv[2][2];
#pragma unroll
            for (int h = 0; h < 2; ++h) { xv[h][0] = __builtin_nontemporal_load((const f32x4*)(xin + row * D + h * 512 + 8 * F.lane)); xv[h][1] = __builtin_nontemporal_load((const f32x4*)(xin + row * D + h * 512 + 8 * F.lane + 4)); }
#pragma unroll
            for (int h = 0; h < 2; ++h) { const int col = h * 512 + 8 * F.lane; float xs[8], uo[8];
#pragma unroll
                for (int q = 0; q < 2; ++q) { const f32x4 s1 = *(const LAS f32x4*)(sc + col + 4 * q), s0 = *(const LAS f32x4*)(sh + col + 4 * q);
#pragma unroll
                    for (int j = 0; j < 4; ++j) { xs[4 * q + j] = xv[h][q][j]; uo[4 * q + j] = xv[h][q][j] * s1[j] + s0[j]; } }
                *(u32x4*)(xbo + row * D + col) = pack8(xs);
                *(u32x2*)(uq + row * D + col) = (u32x2){pk4_fp8(uo[0], uo[1], uo[2], uo[3]), pk4_fp8(uo[4], uo[5], uo[6], uo[7])}; }
        }
    }
}

struct Prob1 {
    static constexpr bool GATHER = false;
    int tid;
    int K; StaticOrderC<M / 256, INW / 256> S; const char* A; const char* Bt; bf16* vp; const LAS float* b_in;
    __device__ __forceinline__ bool next(int i, Unit& u) const { return S.next(i, u); }
    __device__ __forceinline__ void resolve(const Unit& u, int, const char*& a, const char*& b, unsigned& o00, unsigned& o01, unsigned& o10, unsigned& o11) const {
        a = A + (size_t)u.pm * 256 * D; b = Bt + (size_t)u.pn * 256 * D; pg8::lin_offsets(tid, D, o00, o01, o10, o11); }
    __device__ __forceinline__ void epi(const Unit& u, int, const f32x4 (&acc)[2][2][4][2], int wr, int wc, int fr, int fq) const { const Epi1 E{vp, b_in, u.pm * 256, u.pn}; pg8::run_epi(E, acc, wr, wc, fr, fq); }
};
__device__ __forceinline__ void phase_gemm1(int l) {
    const Frame F = make_frame();
    const KArgs ka = kargs_fresh(); unsigned char* const ws = ka->ws;
    Prob1 P; P.tid = F.tid; P.K = D; P.S.init(M / 256, INW / 256, F.G, F.bid); P.A = (const char*)(ws + WS_A); P.Bt = (const char*)(ws + WS_WIN) + (size_t)l * INW * D; P.vp = (bf16*)(ws + WS_B);
    { LAS float* bl = (LAS float*)(F.lds + LDS_EPIC); const float* bg = ka->in[I_BIN] + l * INW; for (int i = F.tid; i < INW; i += NT) bl[i] = bg[i]; P.b_in = bl; __syncthreads(); }
    pg8::gemm_phase<Prob1, true, true>(F.lds, P, F.tid);
}

__device__ __forceinline__ void phase_convpool(int l) {
    const Frame F = make_frame();
    const KArgs ka = kargs_fresh(); unsigned char* const ws = ka->ws;
    const bf16* __restrict__ vp = (const bf16*)(ws + WS_B); bf16* __restrict__ A2 = (bf16*)(ws + WS_A);
    const float* cw = ka->in[I_CONVW] + l * CK * CW; const float* cb = ka->in[I_CONVB] + l * CW; const float* lg = ka->in[I_CLNG] + l * CW; const float* lb = ka->in[I_CLNB] + l * CW;
    LAS bf16* vin = (LAS bf16*)F.lds;
    LAS float* yo = (LAS float*)(F.lds + 63488);
    const int cp = F.tid & 255, rh = F.tid >> 8, chunk = F.tid & 63, prow = F.tid >> 6;
    h16x2 w2[CK];
#pragma unroll
    for (int j = 0; j < CK; ++j) w2[j] = __builtin_convertvector(*(const f32x2*)(cw + j * CW + 2 * cp), h16x2);
    const f32x2 cb2 = *(const f32x2*)(cb + 2 * cp);
    const f32x4 ga = *(const f32x4*)(lg + 8 * F.lane), gb = *(const f32x4*)(lg + 8 * F.lane + 4), ba = *(const f32x4*)(lb + 8 * F.lane), bb = *(const f32x4*)(lb + 8 * F.lane + 4);
    u32x4 vreg[8], preg[6];
#define CP_LOADV(tile_) do { const int row0_ = (tile_) * 32, t0_ = row0_ & (SEQ - 1); _Pragma("unroll") for (int pass = 0; pass < 8; ++pass) { const int r = pass * 8 + prow; vreg[pass] = (u32x4){0u, 0u, 0u, 0u}; \
        if (r < 62 && t0_ - 30 + r >= 0) vreg[pass] = __builtin_nontemporal_load((const u32x4*)(vp + (size_t)(row0_ - 30 + r) * D + chunk * 8)); } } while (0)
#define CP_LOADP(tile_) do { const int row0_ = (tile_) * 32, t0_ = row0_ & (SEQ - 1); _Pragma("unroll") for (int pass = 0; pass < 6; ++pass) { const int r = pass * 8 + prow; preg[pass] = (u32x4){0u, 0u, 0u, 0u}; \
        if (r < 47 && t0_ - 15 + r >= 0) preg[pass] = __builtin_nontemporal_load((const u32x4*)(vp + (size_t)(row0_ - 15 + r) * D + 512 + chunk * 8)); } } while (0)
    const bool owned = (F.G == M / 256);
    const int tstep = owned ? 1 : F.G, tend = owned ? 8 * F.bid + 8 : M / 32;
    int tile = owned ? 8 * F.bid : F.bid;
    if (tile < tend) CP_LOADV(tile);
#pragma unroll 1
    for (; tile < tend; tile += tstep) {
        const int row0 = tile * 32, t0 = row0 & (SEQ - 1);
#pragma unroll
        for (int pass = 0; pass < 8; ++pass) { const int r = pass * 8 + prow; if (r < 62) *(LAS u32x4*)(vin + r * 512 + chunk * 8) = vreg[pass]; }
        __syncthreads();
        if (tile + tstep < tend) CP_LOADV(tile + tstep);
        CP_LOADP(tile);
#pragma unroll 1
        for (int strip = 0; strip < 2; ++strip) {
            const int o0 = rh * 16 + strip * 8;
            h16x2 a2[8];
#pragma unroll
            for (int o = 0; o < 8; ++o) a2[o] = (h16x2){(_Float16)0.f, (_Float16)0.f};
            unsigned xr[38];
#pragma unroll
            for (int j = 0; j < 38; ++j) xr[j] = *(const LAS unsigned*)(vin + (o0 + j) * 512 + 2 * cp);
#pragma unroll
            for (int j = 0; j < 38; ++j) { const h16x2 x2 = __builtin_bit_cast(h16x2, xr[j]);
#pragma unroll
                for (int o = 0; o < 8; ++o) { const int tap = j - o; if (tap >= 0 && tap < CK) a2[o] += w2[tap] * x2; } }
#pragma unroll
            for (int o = 0; o < 8; ++o) *(LAS f32x2*)(yo + (o0 + o) * 512 + 2 * cp) = (f32x2){(float)a2[o].x + cb2.x, (float)a2[o].y + cb2.y};
        }
        __syncthreads();
#pragma unroll
        for (int pass = 0; pass < 6; ++pass) { const int r = pass * 8 + prow; if (r < 47) *(LAS u32x4*)(vin + r * 512 + chunk * 8) = preg[pass]; }
#pragma unroll 1
        for (int rr = 0; rr < 4; ++rr) { const int r = F.wave * 4 + rr;
            const f32x4 a = *(const LAS f32x4*)(yo + r * 512 + 8 * F.lane), b = *(const LAS f32x4*)(yo + r * 512 + 8 * F.lane + 4);
            const float mean = wave_sum((a[0] + a[1]) + (a[2] + a[3]) + (b[0] + b[1]) + (b[2] + b[3])) * (1.0f / 512.0f);
            const f32x4 da = a - mean, db = b - mean;
            const float var = wave_sum((da[0] * da[0] + da[1] * da[1]) + (da[2] * da[2] + da[3] * da[3]) + (db[0] * db[0] + db[1] * db[1]) + (db[2] * db[2] + db[3] * db[3])) * (1.0f / 512.0f);
            const float rstd = __builtin_amdgcn_rsqf(var + LN_EPS);
            float o[8];
#pragma unroll
            for (int j = 0; j < 4; ++j) { const float ya = da[j] * rstd * ga[j] + ba[j], yb = db[j] * rstd * gb[j] + bb[j]; o[j] = ya * sigmoidf_(ya); o[4 + j] = yb * sigmoidf_(yb); }
            *(u32x2*)((unsigned char*)A2 + (size_t)(row0 + r) * D + 8 * F.lane) = (u32x2){pk4_fp8(o[0], o[1], o[2], o[3]), pk4_fp8(o[4], o[5], o[6], o[7])};
        }
        __syncthreads();
        {
            const int w = 2 << (chunk >> 4), o0 = F.wave * 4;
            float sacc[8];
#pragma unroll
            for (int j = 0; j < 8; ++j) sacc[j] = 0.f;
#pragma unroll
            for (int i = 1; i < 16; ++i) { if (i < w) { float e[8]; unpack8(*(const LAS u32x4*)(vin + (o0 + 15 - i) * 512 + chunk * 8), e);
#pragma unroll
                    for (int j = 0; j < 8; ++j) sacc[j] += e[j]; } }
#pragma unroll
            for (int o = 0; o < 4; ++o) { const int li = o0 + o + 15; float cur[8]; unpack8(*(const LAS u32x4*)(vin + li * 512 + chunk * 8), cur);
                const int t = t0 + o0 + o; const float inv = __builtin_amdgcn_rcpf((float)((t + 1) < w ? (t + 1) : w)); float dd[8];
#pragma unroll
                for (int j = 0; j < 8; ++j) { sacc[j] += cur[j]; dd[j] = sacc[j] * inv - cur[j]; }
                *(u32x2*)((unsigned char*)A2 + (size_t)(row0 + o0 + o) * D + 512 + chunk * 8) = (u32x2){pk4_fp8(dd[0], dd[1], dd[2], dd[3]), pk4_fp8(dd[4], dd[5], dd[6], dd[7])};
                float old[8]; unpack8(*(const LAS u32x4*)(vin + (li - (w - 1)) * 512 + chunk * 8), old);
#pragma unroll
                for (int j = 0; j < 8; ++j) sacc[j] -= old[j]; }
        }
        __syncthreads();
    }
#undef CP_LOADV
#undef CP_LOADP
}

struct Prob2 {
    static constexpr bool GATHER = false;
    int tid;
    int K; StaticOrderC<M / 256, D / 256> S; const char* A; const char* Bt; bf16* y; const bf16* xb; const LAS float* bo; const LAS float* gg; float* part;
    __device__ __forceinline__ bool next(int i, Unit& u) const { return S.next(i, u); }
    __device__ __forceinline__ void resolve(const Unit& u, int, const char*& a, const char*& b, unsigned& o00, unsigned& o01, unsigned& o10, unsigned& o11) const {
        a = A + (size_t)u.pm * 256 * D; b = Bt + (size_t)u.pn * 256 * D; pg8::lin_offsets(tid, D, o00, o01, o10, o11); }
    __device__ __forceinline__ void epi(const Unit& u, int, const f32x4 (&acc)[2][2][4][2], int wr, int wc, int fr, int fq) const {
        const Epi2 E{y, xb, bo, gg, part, u.pm * 256, u.pn}; pg8::run_epi(E, acc, wr, wc, fr, fq); }
};
__device__ __forceinline__ void phase_gemm2(int l) {
    const Frame F = make_frame();
    const KArgs ka = kargs_fresh(); unsigned char* const ws = ka->ws;
    Prob2 P; P.tid = F.tid; P.K = D; P.S.init(M / 256, D / 256, F.G, F.bid); P.A = (const char*)(ws + WS_A); P.Bt = (const char*)(ws + WS_WOUT) + (size_t)l * D * D; P.y = (bf16*)(ws + WS_C);
    P.xb = (const bf16*)(ws + WS_E); P.part = (float*)(ws + WS_PART);
    {
        LAS float* bl = (LAS float*)(F.lds + LDS_EPIC); LAS float* gl = bl + D; const float* bg = ka->in[I_BOUT] + l * D; const float* gm = (const float*)(ws + WS_MOD) + (size_t)(l * NB + (F.bid >> 5)) * 6 * D + 2 * D;
        for (int i = F.tid; i < D; i += NT) { bl[i] = bg[i]; gl[i] = 1.0f + gm[i]; } P.bo = bl; P.gg = gl; __syncthreads(); }
    pg8::gemm_phase<Prob2, true, true>(F.lds, P, F.tid);
}

__device__ __forceinline__ void phase_ln1route(int l) {
    const Frame F = make_frame();
    const KArgs ka = kargs_fresh(); unsigned char* const ws = ka->ws;
    const bf16* __restrict__ y = (const bf16*)(ws + WS_C); unsigned char* __restrict__ u2q = ws + WS_A;
    const float* mod = (const float*)(ws + WS_MOD); float* stats = (float*)(ws + WS_STATS); const float* part = (const float*)(ws + WS_PART);
    const bf16* wr_hi = (const bf16*)(ws + WS_WR); const bf16* wr_lo = wr_hi + NE * D;
    unsigned* gcount = (unsigned*)(ws + WS_CTL) + CW_CNT + l * NE;
    int* listd = (int*)(ws + WS_LISTD); float* listw = (float*)(ws + WS_LISTW);
    LAS float* Pc = (LAS float*)F.lds; LAS float* Qc = Pc + D;
    LAS float* lgw = (LAS float*)(F.lds + 8192) + F.wave * 32 * 33;
    LAS int* lcnt = (LAS int*)(F.lds + 8192 + 8 * 32 * 33 * 4);
    LAS int* gbase = lcnt + 32;
    LAS int* asg_e = gbase + 32; LAS int* asg_r = asg_e + 512; LAS int* asg_d = asg_r + 512; LAS float* asg_w = (LAS float*)(asg_d + 512);
    const int fr = F.lane & 15, fq = F.lane >> 4;
    const float* rb = ka->in[I_RB];
    for (int chunk = F.bid; chunk < M / 256; chunk += F.G) {
        const int b = chunk >> 5;
        __syncthreads();
        for (int i = F.tid; i < D; i += NT) { const float g = ka->in[I_LN1G][l * D + i], bb = ka->in[I_LN1B][l * D + i];
            const float sc2 = 1.0f + mod[(size_t)(l * NB + b) * 6 * D + 4 * D + i], sh2 = mod[(size_t)(l * NB + b) * 6 * D + 3 * D + i];
            Pc[i] = g * sc2; Qc[i] = bb * sc2 + sh2; }
        if (F.tid < 32) lcnt[F.tid] = 0;
        __syncthreads();
        const int R0 = chunk * 256 + F.wave * 32;
        float mu[2], rs[2];
#pragma unroll
        for (int m = 0; m < 2; ++m) {
            const float* pp = part + ((size_t)(4 * fq) * M + R0 + 16 * m + fr) * 2;
            const f32x2 p0 = *(const f32x2*)pp, p1 = *(const f32x2*)(pp + (size_t)2 * M), p2 = *(const f32x2*)(pp + (size_t)4 * M), p3 = *(const f32x2*)(pp + (size_t)6 * M);
            float s = (p0.x + p1.x) + (p2.x + p3.x), q = (p0.y + p1.y) + (p2.y + p3.y);
            s += __shfl_xor(s, 16); s += __shfl_xor(s, 32); q += __shfl_xor(q, 16); q += __shfl_xor(q, 32);
            const float mean = s * (1.0f / D); float var = q * (1.0f / D) - mean * mean; var = var < 0.f ? 0.f : var;
            mu[m] = mean; rs[m] = __builtin_amdgcn_rsqf(var + LN_EPS);
            if (fq == 0) *(f32x2*)(stats + (size_t)(R0 + 16 * m + fr) * 2) = (f32x2){mean, rs[m]};
        }
        f32x4 acc[2][2];
#pragma unroll
        for (int m = 0; m < 2; ++m)
#pragma unroll
            for (int n = 0; n < 2; ++n) acc[m][n] = (f32x4){0.f, 0.f, 0.f, 0.f};
        const bf16* yr0 = y + (size_t)(R0 + fr) * D + 16 * fq; const bf16* yr1 = yr0 + (size_t)16 * D;
        unsigned char* ur0 = u2q + (size_t)(R0 + fr) * D + 16 * fq; unsigned char* ur1 = ur0 + (size_t)16 * D;
        const bf16* wh0 = wr_hi + (size_t)fr * D + 16 * fq; const bf16* wl0 = wr_lo + (size_t)fr * D + 16 * fq;
        u32x4 yc[2][2]; bf16x8 bhc[2][2], blc[2][2];
#pragma unroll
        for (int c = 0; c < 2; ++c) { yc[0][c] = *(const u32x4*)(yr0 + 8 * c); yc[1][c] = *(const u32x4*)(yr1 + 8 * c);
#pragma unroll
            for (int n = 0; n < 2; ++n) { bhc[n][c] = *(const bf16x8*)(wh0 + (size_t)n * 16 * D + 8 * c); blc[n][c] = *(const bf16x8*)(wl0 + (size_t)n * 16 * D + 8 * c); } }
#pragma unroll 1
        for (int it = 0; it < 16; ++it) {
            const int k = 64 * it + 16 * fq, kn = (it < 15) ? 64 * (it + 1) : 0;
            u32x4 yn[2][2]; bf16x8 bhn[2][2], bln[2][2];
#pragma unroll
            for (int c = 0; c < 2; ++c) { yn[0][c] = *(const u32x4*)(yr0 + kn + 8 * c); yn[1][c] = *(const u32x4*)(yr1 + kn + 8 * c);
#pragma unroll
                for (int n = 0; n < 2; ++n) { bhn[n][c] = *(const bf16x8*)(wh0 + (size_t)n * 16 * D + kn + 8 * c); bln[n][c] = *(const bf16x8*)(wl0 + (size_t)n * 16 * D + kn + 8 * c); } }
            float pc[16], qc[16];
#pragma unroll
            for (int c4 = 0; c4 < 4; ++c4) { const f32x4 pv = *(const LAS f32x4*)(Pc + k + 4 * c4), qv = *(const LAS f32x4*)(Qc + k + 4 * c4);
#pragma unroll
                for (int j = 0; j < 4; ++j) { pc[4 * c4 + j] = pv[j]; qc[4 * c4 + j] = qv[j]; } }
            bf16x8 ah[2][2], al[2][2];
#pragma unroll
            for (int m = 0; m < 2; ++m) {
                float uv[16];
#pragma unroll
                for (int c = 0; c < 2; ++c) { float e[8]; unpack8(yc[m][c], e);
#pragma unroll
                    for (int j = 0; j < 8; ++j) uv[8 * c + j] = (e[j] - mu[m]) * rs[m] * pc[8 * c + j] + qc[8 * c + j]; }
                *(u32x4*)((m ? ur1 : ur0) + 64 * it) = (u32x4){pk4_fp8(uv[0], uv[1], uv[2], uv[3]), pk4_fp8(uv[4], uv[5], uv[6], uv[7]), pk4_fp8(uv[8], uv[9], uv[10], uv[11]), pk4_fp8(uv[12], uv[13], uv[14], uv[15])};
#pragma unroll
                for (int c = 0; c < 2; ++c) { float h8[8], d8[8];
#pragma unroll
                    for (int j = 0; j < 8; ++j) h8[j] = uv[8 * c + j];
                    const u32x4 hv = pack8(h8); float hb[8]; unpack8(hv, hb);
#pragma unroll
                    for (int j = 0; j < 8; ++j) d8[j] = h8[j] - hb[j];
                    ah[m][c] = __builtin_bit_cast(bf16x8, hv); al[m][c] = __builtin_bit_cast(bf16x8, pack8(d8)); }
            }
#pragma unroll
            for (int c = 0; c < 2; ++c)
#pragma unroll
                for (int n = 0; n < 2; ++n)
#pragma unroll
                    for (int m = 0; m < 2; ++m) {
                        acc[m][n] = __builtin_amdgcn_mfma_f32_16x16x32_bf16(bhc[n][c], ah[m][c], acc[m][n], 0, 0, 0);
                        acc[m][n] = __builtin_amdgcn_mfma_f32_16x16x32_bf16(bhc[n][c], al[m][c], acc[m][n], 0, 0, 0);
                        acc[m][n] = __builtin_amdgcn_mfma_f32_16x16x32_bf16(blc[n][c], ah[m][c], acc[m][n], 0, 0, 0);
                    }
#pragma unroll
            for (int c = 0; c < 2; ++c) { yc[0][c] = yn[0][c]; yc[1][c] = yn[1][c];
#pragma unroll
                for (int n = 0; n < 2; ++n) { bhc[n][c] = bhn[n][c]; blc[n][c] = bln[n][c]; } }
        }
#pragma unroll
        for (int m = 0; m < 2; ++m)
#pragma unroll
            for (int n = 0; n < 2; ++n)
#pragma unroll
                for (int j = 0; j < 4; ++j) lgw[(16 * m + fr) * 33 + 16 * n + 4 * fq + j] = acc[m][n][j];
        LDS_WAIT();
        if (F.lane < 32) {
            float bestg = -1e30f; int be0 = 0, be1 = 0; float bs0 = 0.f, bs1 = 0.f;
#pragma unroll 1
            for (int g = 0; g < 4; ++g) {
                float m1 = -1e30f, m2 = -1e30f, s1 = 0.f, s2 = 0.f; int i1 = 0, i2 = 0;
#pragma unroll
                for (int i = 0; i < 8; ++i) { const int e = g * 8 + i; const float sc = sigmoidf_(lgw[F.lane * 33 + e]); const float sel = sc + rb[e];
                    if (sel > m1) { m2 = m1; i2 = i1; s2 = s1; m1 = sel; i1 = e; s1 = sc; } else if (sel > m2) { m2 = sel; i2 = e; s2 = sc; } }
                const float gs = m1 + m2;
                if (gs > bestg) { bestg = gs; be0 = i1; be1 = i2; bs0 = s1; bs1 = s2; }
            }
            const float inv = __builtin_amdgcn_rcpf(bs0 + bs1);
            const int tok = R0 + F.lane, slot = F.wave * 64 + F.lane * 2;
            const int r0 = atomicAdd((int*)&lcnt[be0], 1); const int r1 = atomicAdd((int*)&lcnt[be1], 1);
            asg_e[slot] = be0; asg_r[slot] = r0; asg_d[slot] = tok * 2; asg_w[slot] = bs0 * inv;
            asg_e[slot + 1] = be1; asg_r[slot + 1] = r1; asg_d[slot + 1] = tok * 2 + 1; asg_w[slot + 1] = bs1 * inv;
        }
        __syncthreads();
        if (F.tid < 32) gbase[F.tid] = (int)atomicAdd(&gcount[F.tid], (unsigned)lcnt[F.tid]);
        __syncthreads();
        { const int e = asg_e[F.tid], pos = gbase[e] + asg_r[F.tid]; listd[e * LISTCAP + pos] = asg_d[F.tid]; listw[e * LISTCAP + pos] = asg_w[F.tid]; }
    }
}

constexpr int LDS_ULIST = 131 * 1024;
constexpr int LDS_TILEE = 128 * 1024, LDS_TOFF = 132 * 1024, LDS_TABW = 134 * 1024, LDS_TAB = 145 * 1024, MOE_MAXU = 10;
__device__ __forceinline__ void moe_table(const Frame& F, const unsigned char* ws, int l, LAS int* toff, LAS int* ncnt, LAS int* tile_e) {
    const unsigned* gcount = (const unsigned*)(ws + WS_CTL) + CW_CNT + l * NE;
    __syncthreads();
    if (F.tid < NE) ncnt[F.tid] = (int)__hip_atomic_load(gcount + F.tid, __ATOMIC_RELAXED, __HIP_MEMORY_SCOPE_AGENT);
    __syncthreads();
    if (F.tid == 0) { int acc = 0; for (int e = 0; e < NE; ++e) { toff[e] = acc; acc += (ncnt[e] + 255) >> 8; } toff[NE] = acc; }
    __syncthreads();
    for (int pm = F.tid; pm < toff[NE]; pm += NT) { int e = 0; while (e < NE - 1 && toff[e + 1] <= pm) ++e; tile_e[pm] = e; }
    __syncthreads();
}

struct Prob3 {
    static constexpr bool GATHER = true;
    int tid;
    int K; StaticOrder S; const LAS int* toff; const LAS int* ncnt; const LAS int* tile_e; const LAS int* tab; const LAS int* ulist; const char* u2; const char* W; const int* listd; unsigned char* hm;
    __device__ __forceinline__ bool next(int i, Unit& u) const { if (i >= MOE_MAXU) return false; const int v = ulist[i]; u.pm = v >> 2; u.pn = v & 3; return v >= 0; }
    __device__ __forceinline__ void resolve(const Unit& u, int i, const char*& a, const char*& b, unsigned& o00, unsigned& o01, unsigned& o10, unsigned& o11) const {
        const int e = tile_e[u.pm];
        a = u2; b = W + (size_t)e * D * D + (size_t)u.pn * 256 * D;
        int R0, C0, R1, C1; pg8::stage_rc(tid * 16, R0, C0); pg8::stage_rc(tid * 16 + 8192, R1, C1);
        const LAS int* t = tab + i * 256; const int t00 = t[R0], t01 = t[R1], t10 = t[R0 + 128], t11 = t[R1 + 128];
        o00 = (unsigned)(t00 * D + C0 * 2); o01 = (unsigned)(t01 * D + C1 * 2); o10 = (unsigned)(t10 * D + C0 * 2); o11 = (unsigned)(t11 * D + C1 * 2);
    }
    __device__ __forceinline__ void epi(const Unit& u, int i, const f32x4 (&acc)[2][2][4][2], int wr, int wc, int fr, int fq) const { const Epi3 E{hm, u.pm * 256, u.pn}; pg8::run_epi(E, acc, wr, wc, fr, fq); }
};
struct Prob4 {
    static constexpr bool GATHER = false;
    int tid;
    int K; StaticOrder S; const LAS int* toff; const LAS int* ncnt; const LAS int* tile_e; const LAS int* tabd; const LAS float* tabw; const LAS int* ulist; const char* hm; const char* W; const int* listd; const float* listw; unsigned char* ct;
    __device__ __forceinline__ bool next(int i, Unit& u) const { if (i >= MOE_MAXU) return false; const int v = ulist[i]; u.pm = v >> 2; u.pn = v & 3; return v >= 0; }
    __device__ __forceinline__ void resolve(const Unit& u, int i, const char*& a, const char*& b, unsigned& o00, unsigned& o01, unsigned& o10, unsigned& o11) const {
        const int e = tile_e[u.pm];
        a = hm + (size_t)u.pm * 256 * FE; b = W + (size_t)e * D * FE + (size_t)u.pn * 256 * FE; pg8::lin_offsets(tid, FE, o00, o01, o10, o11); }
    __device__ __forceinline__ void epi(const Unit& u, int i, const f32x4 (&acc)[2][2][4][2], int wr, int wc, int fr, int fq) const {
        const Epi4<3> E{ct, tabd + i * 256, tabw + i * 256, u.pn}; pg8::run_epi(E, acc, wr, wc, fr, fq);
    }
};
__device__ __forceinline__ void phase_gemm3(int l) {
    const Frame F = make_frame();
    const KArgs ka = kargs_fresh(); unsigned char* const ws = ka->ws;
    LAS int* toff = (LAS int*)(F.lds + LDS_TOFF); LAS int* ncnt = toff + 40; LAS int* tile_e = (LAS int*)(F.lds + LDS_TILEE); LAS int* tab = (LAS int*)(F.lds + LDS_TAB);
    moe_table(F, ws, l, toff, ncnt, tile_e);
    Prob3 P; P.tid = F.tid; P.K = D; P.S.init(toff[NE], 4, F.G, F.bid); P.toff = toff; P.ncnt = ncnt; P.tile_e = tile_e; P.tab = tab; P.u2 = (const char*)(ws + WS_A); P.W = (const char*)(ws + WS_WGU) + (size_t)l * NE * D * D;
    P.listd = (const int*)(ws + WS_LISTD); P.hm = (unsigned char*)(ws + WS_B);
    { LAS int* ul = (LAS int*)(F.lds + LDS_ULIST); P.ulist = ul; if (F.tid < MOE_MAXU) { Unit u; ul[F.tid] = P.S.next(F.tid, u) ? (u.pm * 4 + u.pn) : -1; } __syncthreads(); }
    {
        const int r = F.tid & 255, i0 = F.tid >> 8; int v[MOE_MAXU / 2];
#pragma unroll
        for (int k = 0; k < MOE_MAXU / 2; ++k) { Unit u; v[k] = 0; if (P.next(i0 + 2 * k, u)) { const int e = tile_e[u.pm], ti = u.pm - toff[e]; if (r < ncnt[e] - ti * 256) v[k] = P.listd[e * LISTCAP + ti * 256 + r] >> 1; } }
#pragma unroll
        for (int k = 0; k < MOE_MAXU / 2; ++k) tab[(i0 + 2 * k) * 256 + r] = v[k];
        __syncthreads();
    }
    pg8::gemm_phase<Prob3, true, true>(F.lds, P, F.tid);
}
__device__ __forceinline__ void phase_gemm4(int l) {
    const Frame F = make_frame();
    const KArgs ka = kargs_fresh(); unsigned char* const ws = ka->ws;
    LAS int* toff = (LAS int*)(F.lds + LDS_TOFF); LAS int* ncnt = toff + 40; LAS int* tile_e = (LAS int*)(F.lds + LDS_TILEE); LAS int* tabd = (LAS int*)(F.lds + LDS_TAB); LAS float* tabw = (LAS float*)(F.lds + LDS_TABW);
    moe_table(F, ws, l, toff, ncnt, tile_e);
    Prob4 P; P.tid = F.tid; P.K = FE; P.S.init(toff[NE], 4, F.G, F.bid); P.toff = toff; P.ncnt = ncnt; P.tile_e = tile_e; P.tabd = tabd; P.tabw = tabw; P.hm = (const char*)(ws + WS_B); P.W = (const char*)(ws + WS_WD) + (size_t)l * NE * D * FE;
    P.listd = (const int*)(ws + WS_LISTD); P.listw = (const float*)(ws + WS_LISTW); P.ct = ws + WS_D;
    { LAS int* ul = (LAS int*)(F.lds + LDS_ULIST); P.ulist = ul; if (F.tid < MOE_MAXU) { Unit u; ul[F.tid] = P.S.next(F.tid, u) ? (u.pm * 4 + u.pn) : -1; } __syncthreads(); }
    {
        const int r = F.tid & 255, i0 = F.tid >> 8; int vd[MOE_MAXU / 2]; float vw[MOE_MAXU / 2];
#pragma unroll
        for (int k = 0; k < MOE_MAXU / 2; ++k) { Unit u; vd[k] = -1; vw[k] = 0.f; if (P.next(i0 + 2 * k, u)) { const int e = tile_e[u.pm], ti = u.pm - toff[e]; if (r < ncnt[e] - ti * 256) { vd[k] = P.listd[e * LISTCAP + ti * 256 + r]; vw[k] = P.listw[e * LISTCAP + ti * 256 + r] * 0.25f; } } }
#pragma unroll
        for (int k = 0; k < MOE_MAXU / 2; ++k) { tabd[(i0 + 2 * k) * 256 + r] = vd[k]; tabw[(i0 + 2 * k) * 256 + r] = vw[k]; }
        __syncthreads();
    }
    pg8::gemm_phase<Prob4, true, true>(F.lds, P, F.tid);
}

__device__ __forceinline__ void unpack_fp8x16(const u32x4 v, float (&e)[16]) {
#pragma unroll
    for (int q = 0; q < 4; ++q) { const unsigned w = v[q]; const f32x2 lo = __builtin_amdgcn_cvt_pk_f32_fp8(w, false), hi = __builtin_amdgcn_cvt_pk_f32_fp8(w, true); e[4 * q] = lo[0]; e[4 * q + 1] = lo[1]; e[4 * q + 2] = hi[0]; e[4 * q + 3] = hi[1]; }
}
__device__ __forceinline__ void phase_ln2(int l) {
    const Frame F = make_frame();
    const KArgs ka = kargs_fresh(); unsigned char* const ws = ka->ws;
    const bf16* __restrict__ y = (const bf16*)(ws + WS_C); const unsigned char* __restrict__ ct = ws + WS_D;
    const float* mod = (const float*)(ws + WS_MOD); const float* stats = (const float*)(ws + WS_STATS);
    bf16* __restrict__ x2 = (bf16*)(ws + WS_E); bf16* __restrict__ un = (bf16*)(ws + WS_A); float* __restrict__ outp = ka->out;
    const int gw = F.bid * NWAVES + F.wave, NGW = F.G * NWAVES, rpw = (M + NGW - 1) / NGW;
    const int r0 = gw * rpw, r1 = (r0 + rpw) < M ? (r0 + rpw) : M;
    const int c0 = 16 * F.lane;
    float ag[16], ab[16], g2v[16], b2v[16], mg[16], sc[16], sh[16];
#pragma unroll
    for (int q = 0; q < 4; ++q) { const f32x4 a = *(const f32x4*)(ka->in[I_LN1G] + l * D + c0 + 4 * q), b = *(const f32x4*)(ka->in[I_LN1B] + l * D + c0 + 4 * q), c = *(const f32x4*)(ka->in[I_LN2G] + l * D + c0 + 4 * q), d = *(const f32x4*)(ka->in[I_LN2B] + l * D + c0 + 4 * q);
#pragma unroll
        for (int j = 0; j < 4; ++j) { ag[4 * q + j] = ALPHA * a[j]; ab[4 * q + j] = ALPHA * b[j]; g2v[4 * q + j] = c[j]; b2v[4 * q + j] = d[j]; } }
    int bcur = -1;
    constexpr int RIF = 4;
#pragma unroll 1
    for (int row = r0; row < r1; row += RIF) {
        const int b = row >> 13;
        if (b != bcur) { bcur = b; const float* mb = mod + (size_t)(l * NB + b) * 6 * D; const float* mn = mod + (size_t)((l + 1 < L ? l + 1 : l) * NB + b) * 6 * D;
#pragma unroll
            for (int q = 0; q < 4; ++q) { const f32x4 a = *(const f32x4*)(mb + 5 * D + c0 + 4 * q), c = *(const f32x4*)(mn + D + c0 + 4 * q), d = *(const f32x4*)(mn + c0 + 4 * q);
#pragma unroll
                for (int j = 0; j < 4; ++j) { mg[4 * q + j] = (1.0f + a[j]) * 0.0625f; sc[4 * q + j] = 1.0f + c[j]; sh[4 * q + j] = d[j]; } } }
        u32x4 vy[RIF][2], v0[RIF], v1[RIF]; f32x2 st[RIF];
#pragma unroll
        for (int rr = 0; rr < RIF; ++rr) { const size_t r = (row + rr) < r1 ? (row + rr) : (r1 - 1); st[rr] = *(const f32x2*)(stats + r * 2);
            vy[rr][0] = __builtin_nontemporal_load((const u32x4*)(y + r * D + c0)); vy[rr][1] = __builtin_nontemporal_load((const u32x4*)(y + r * D + c0 + 8)); v0[rr] = __builtin_nontemporal_load((const u32x4*)(ct + (2 * r) * D + c0)); v1[rr] = __builtin_nontemporal_load((const u32x4*)(ct + (2 * r + 1) * D + c0)); }
#pragma unroll
        for (int rr = 0; rr < RIF; ++rr) {
            const size_t r = (row + rr) < r1 ? (row + rr) : (r1 - 1); const bool live = (row + rr) < r1;
            float z[16], e0[16], e1[16], ey[16]; float s = 0.f;
            { float t8[8]; unpack8(vy[rr][0], t8);
#pragma unroll
              for (int j = 0; j < 8; ++j) ey[j] = t8[j];
              unpack8(vy[rr][1], t8);
#pragma unroll
              for (int j = 0; j < 8; ++j) ey[8 + j] = t8[j]; }
            unpack_fp8x16(v0[rr], e0); unpack_fp8x16(v1[rr], e1);
#pragma unroll
            for (int j = 0; j < 16; ++j) { const float v = (ey[j] - st[rr].x) * st[rr].y * ag[j] + ab[j] + mg[j] * (e0[j] + e1[j]); z[j] = v; s += v; }
            const float mean = wave_sum(s) * (1.0f / D); float q = 0.f;
#pragma unroll
            for (int j = 0; j < 16; ++j) { z[j] -= mean; q += z[j] * z[j]; }
            const float rstd = __builtin_amdgcn_rsqf(wave_sum(q) * (1.0f / D) + LN_EPS);
            if (live) {
                float o[16];
#pragma unroll
                for (int j = 0; j < 16; ++j) o[j] = z[j] * rstd * g2v[j] + b2v[j];
                if (l == L - 1) {
#pragma unroll
                    for (int q4 = 0; q4 < 4; ++q4) *(f32x4*)(outp + r * D + c0 + 4 * q4) = (f32x4){o[4 * q4], o[4 * q4 + 1], o[4 * q4 + 2], o[4 * q4 + 3]};
                } else {
                    float uo[16];
#pragma unroll
                    for (int j = 0; j < 16; ++j) uo[j] = o[j] * sc[j] + sh[j];
#pragma unroll
                    for (int h = 0; h < 2; ++h) {
                        *(u32x4*)(x2 + r * D + c0 + 8 * h) = (u32x4){pk2(o[8 * h], o[8 * h + 1]), pk2(o[8 * h + 2], o[8 * h + 3]), pk2(o[8 * h + 4], o[8 * h + 5]), pk2(o[8 * h + 6], o[8 * h + 7])};
                        *(u32x2*)((unsigned char*)un + r * D + c0 + 8 * h) = (u32x2){pk4_fp8(uo[8 * h], uo[8 * h + 1], uo[8 * h + 2], uo[8 * h + 3]), pk4_fp8(uo[8 * h + 4], uo[8 * h + 5], uo[8 * h + 6], uo[8 * h + 7])}; }
                }
            }
        }
    }
}

constexpr int NPH = 2 + 7 * L;
#ifndef DUP
#define DUP -1
#endif
__global__ void __launch_bounds__(NT, 2) mk_fwd(Args args) {
    const int lo = args.ph_lo, hi = args.ph_hi;
    volatile LAS unsigned* misc = (volatile LAS unsigned*)((LAS unsigned char*)lds_raw + LDS_MISC);
    if (threadIdx.x < 16) misc[threadIdx.x] = 0u;
    __syncthreads();
    (void)xcd_barrier_post((unsigned*)(kargs_fresh()->ws + WS_CTL) + CW_BAR, misc);
#define IN(k) (lo <= (k) && (k) < hi)
#define SEAM(k) do { if (IN(k) && IN((k) + 1)) { XcdBarrier xb_; xb_.bar = (unsigned*)(kargs_fresh()->ws + WS_CTL) + CW_BAR; xb_.x = xb_xcc_id(); xb_.st = (volatile LAS unsigned*)((LAS unsigned char*)lds_raw + LDS_MISC); xcd_barrier(xb_); } } while (0)
    const bool owned = (gridDim.x == (unsigned)(M / 256));
#define LSEAM(k) do { if (IN(k) && IN((k) + 1)) { if (owned) { asm volatile("s_waitcnt vmcnt(0)" ::: "memory"); __syncthreads(); } else SEAM(k); } } while (0)
    if (IN(0)) { phase_p0a(); if (DUP == 0) phase_p0a(); }
    SEAM(0);
    if (IN(1)) { phase_p0b(); if (DUP == 1) phase_p0b(); }
    LSEAM(1);
#pragma unroll 1
    for (int l = 0; l < L; ++l) {
        const int pb = 2 + 7 * l;
        if (IN(pb + 0)) { phase_gemm1(l); if (DUP == 2) phase_gemm1(l); }
        SEAM(pb + 0);
        if (IN(pb + 1)) { phase_convpool(l); if (DUP == 3) phase_convpool(l); }
        LSEAM(pb + 1);
        if (IN(pb + 2)) { phase_gemm2(l); if (DUP == 4) phase_gemm2(l); }
        LSEAM(pb + 2);
        if (IN(pb + 3)) { phase_ln1route(l); if (DUP == 5) phase_ln1route(l); }
        SEAM(pb + 3);
        if (IN(pb + 4)) { phase_gemm3(l); if (DUP == 6) phase_gemm3(l); }
        SEAM(pb + 4);
        if (IN(pb + 5)) { phase_gemm4(l); if (DUP == 7) phase_gemm4(l); }
        SEAM(pb + 5);
        if (IN(pb + 6)) { phase_ln2(l); if (DUP == 8) phase_ln2(l); }
        LSEAM(pb + 6);
    }
#undef LSEAM
#undef SEAM
#undef IN
}

extern "C" void kernel_launch(void* const* d_in, const int* in_sizes, int n_in, void* d_out, int out_size, void* d_ws, size_t ws_size, hipStream_t stream) {
    static int grid = 0;
    if (grid == 0) {
        if (n_in != 23 || out_size != M * D || ws_size < WS_END) { fprintf(stderr, "kernel_launch: unexpected shapes (n_in %d out %d ws %zu)\n", n_in, out_size, ws_size); grid = -1; return; }
        int dev = 0, cus = 0;
        if (hipGetDevice(&dev) != hipSuccess || hipDeviceGetAttribute(&cus, hipDeviceAttributeMultiprocessorCount, dev) != hipSuccess) { grid = -1; return; }
        if (hipFuncSetAttribute((const void*)mk_fwd, hipFuncAttributeMaxDynamicSharedMemorySize, LDS_BYTES) != hipSuccess) { fprintf(stderr, "kernel_launch: hipFuncSetAttribute failed\n"); grid = -1; return; }
        int per_cu = 0;
        if (hipOccupancyMaxActiveBlocksPerMultiprocessor(&per_cu, (const void*)mk_fwd, NT, LDS_BYTES) != hipSuccess || per_cu < 1) { fprintf(stderr, "kernel_launch: occupancy query failed (%d)\n", per_cu); (void)hipGetLastError(); grid = -1; return; }
        if (cus != M / 256) { fprintf(stderr, "kernel_launch: built for a %d-CU device (one 256-row tile per workgroup); found %d CUs\n", M / 256, cus); grid = -1; return; }
        if (cus * MOE_MAXU < ((2 * M) / 256 + NE) * 4) { fprintf(stderr, "kernel_launch: %d CUs: more than MOE_MAXU MoE units per workgroup\n", cus); grid = -1; return; }
        grid = cus;
    }
    if (grid < 0) return;
    (void)hipMemsetAsync((char*)d_ws + WS_CTL, 0, CTL_ZERO_BYTES, stream);
    Args a{};
    for (int i = 0; i < 23; ++i) a.in[i] = (const float*)d_in[i];
    a.out = (float*)d_out; a.ws = (unsigned char*)d_ws; a.ph_lo = 0; a.ph_hi = NPH;
    void* kargs[] = {&a};
    const hipError_t e = hipLaunchCooperativeKernel((const void*)mk_fwd, dim3(grid), dim3(NT), kargs, LDS_BYTES, stream);
    if (e != hipSuccess) fprintf(stderr, "kernel_launch: cooperative launch failed: %s (grid %d)\n", hipGetErrorString(e), grid);
}
```
